# Optimizing an MI355X kernel written in HIP

```python
import math
import jax, jax.numpy as jnp
from jax import lax
import numpy as np

D_MODEL = 1024
BATCH = 4
SEQ = 8192
DEPTH = 2

N_MIXERS = 2
N_A_LAYERS = (DEPTH + 1) // 2
N_B_LAYERS = DEPTH // 2
SSM_GROUP = 16
SSM_GROUPS = D_MODEL // SSM_GROUP
SSM_STATE = 64
N_DIR = 2
DT_MIN = 1e-3
DT_MAX = 1e-1
CONV_WIDTH = 3
MEM_LEN = 256
XATTN_HEADS = 4
XATTN_HEAD_DIM = D_MODEL // XATTN_HEADS
D_FF = 4 * D_MODEL
EPS = 1e-6

kernel_name = "hybrid_s5_shortconv_encoder"


def _rmsnorm(x, g):
    xf = x.astype(jnp.float32)
    y = xf * lax.rsqrt(jnp.mean(xf * xf, axis=-1, keepdims=True) + EPS)
    return (y * g.astype(jnp.float32)).astype(x.dtype)


def _ssm_combine(left, right):
    a_l, b_l = left
    a_r, b_r = right
    return a_r * a_l, a_r * b_l + b_r


def _s5_mixer(h, w_in, lam_re, lam_im, log_dt, b_re, b_im, c_re, c_im, d, w_glu, w_out):
    bsz, seq, _ = h.shape
    f32 = jnp.float32
    u = (h @ w_in).astype(f32).reshape(bsz, seq, SSM_GROUPS, SSM_GROUP)
    u_c = u.transpose(1, 0, 2, 3).astype(jnp.complex64)
    y = d.astype(f32)[None, None] * u
    for r in range(N_DIR):
        lam = lax.complex(lam_re[r].astype(f32), lam_im[r].astype(f32))
        dt = jnp.exp(log_dt[r].astype(f32))[:, None]
        a_bar = jnp.exp(lam * dt)
        b = lax.complex(b_re[r].astype(f32), b_im[r].astype(f32))
        b_bar = ((a_bar - 1.0) / lam)[..., None] * b
        bu = jnp.einsum('gph,lbgh->lbgp', b_bar, u_c)
        if r == 1:
            bu = jnp.flip(bu, axis=0)
        a_seq = jnp.broadcast_to(a_bar[None, None], (seq, 1) + a_bar.shape)
        _, states = lax.associative_scan(_ssm_combine, (a_seq, bu), axis=0)
        if r == 1:
            states = jnp.flip(states, axis=0)
        c = lax.complex(c_re[r].astype(f32), c_im[r].astype(f32))
        y = y + jnp.einsum('ghp,lbgp->blgh', c, states).real
    z = jax.nn.gelu(y.reshape(bsz, seq, D_MODEL))
    z = z * jax.nn.sigmoid(z @ w_glu.astype(f32))
    return (z @ w_out.astype(f32)).astype(h.dtype)


def _short_conv_mixer(h, w_in, conv_w, w_out):
    bcv = h @ w_in
    gate_b, gate_c, v = jnp.split(bcv, 3, axis=-1)
    z = gate_b * v
    pad = CONV_WIDTH // 2
    z = lax.conv_general_dilated(
        z, conv_w[:, None, :].astype(z.dtype), window_strides=(1,),
        padding=[(pad, pad)], dimension_numbers=('NWC', 'WIO', 'NWC'),
        feature_group_count=D_MODEL)
    return (gate_c * z) @ w_out


def _memory_xattn(h, m, w_q, w_kv, w_o):
    bsz, seq, _ = h.shape
    q = (h @ w_q).reshape(bsz, seq, XATTN_HEADS, XATTN_HEAD_DIM)
    k, v = jnp.split(m @ w_kv, 2, axis=-1)
    k = k.reshape(bsz, MEM_LEN, XATTN_HEADS, XATTN_HEAD_DIM)
    v = v.reshape(bsz, MEM_LEN, XATTN_HEADS, XATTN_HEAD_DIM)
    s = jnp.einsum('blnd,bmnd->bnlm', q, k).astype(jnp.float32) * (XATTN_HEAD_DIM ** -0.5)
    p = jax.nn.softmax(s, axis=-1).astype(v.dtype)
    o = jnp.einsum('bnlm,bmnd->blnd', p, v).reshape(bsz, seq, D_MODEL)
    return o @ w_o


def _sq_relu_mlp(h, w1, w2):
    a = jax.nn.relu(h @ w1)
    return (a * a) @ w2


def setup_inputs(seed: int = 0) -> dict:
    key = jax.random.key(seed)
    ks = iter(jax.random.split(key, 40))
    f32 = jnp.float32

    def nrm(shape, fan_in):
        return jax.random.normal(next(ks), shape, f32) * (fan_in ** -0.5)

    def gain(shape):
        return 1.0 + 0.02 * jax.random.normal(next(ks), shape, f32)

    x = jax.random.normal(next(ks), (BATCH, SEQ, D_MODEL), f32)
    mem = jax.random.normal(next(ks), (BATCH, MEM_LEN, D_MODEL), f32)
    norm_mix = gain((DEPTH, D_MODEL))
    norm_xattn = gain((DEPTH, D_MODEL))
    norm_mem = gain((DEPTH, D_MODEL))
    norm_ffn = gain((DEPTH, D_MODEL))
    norm_final = gain((D_MODEL,))

    na = N_A_LAYERS
    a_w_in = nrm((na, D_MODEL, D_MODEL), D_MODEL)
    ssm_shape = (na, N_DIR, SSM_GROUPS, SSM_STATE)
    a_lambda_re = -0.5 + 0.01 * jax.random.normal(next(ks), ssm_shape, f32)
    a_lambda_im = (math.pi * jnp.arange(SSM_STATE, dtype=f32)
                   + 0.01 * jax.random.normal(next(ks), ssm_shape, f32))
    a_log_dt = jax.random.uniform(next(ks), (na, N_DIR, SSM_GROUPS), f32,
                                  minval=math.log(DT_MIN), maxval=math.log(DT_MAX))
    a_b_re = nrm((na, N_DIR, SSM_GROUPS, SSM_STATE, SSM_GROUP), 2 * SSM_GROUP)
    a_b_im = nrm((na, N_DIR, SSM_GROUPS, SSM_STATE, SSM_GROUP), 2 * SSM_GROUP)
    a_c_re = nrm((na, N_DIR, SSM_GROUPS, SSM_GROUP, SSM_STATE), 2 * SSM_STATE)
    a_c_im = nrm((na, N_DIR, SSM_GROUPS, SSM_GROUP, SSM_STATE), 2 * SSM_STATE)
    a_d = jax.random.normal(next(ks), (na, SSM_GROUPS, SSM_GROUP), f32)
    a_w_glu = nrm((na, D_MODEL, D_MODEL), D_MODEL)
    a_w_out = nrm((na, D_MODEL, D_MODEL), D_MODEL)

    nb = N_B_LAYERS
    b_w_in = nrm((nb, D_MODEL, 3 * D_MODEL), D_MODEL)
    b_conv_w = nrm((nb, CONV_WIDTH, D_MODEL), CONV_WIDTH)
    b_w_out = nrm((nb, D_MODEL, D_MODEL), D_MODEL)

    x_w_q = nrm((DEPTH, D_MODEL, D_MODEL), D_MODEL)
    x_w_kv = nrm((DEPTH, D_MODEL, 2 * D_MODEL), D_MODEL)
    x_w_o = nrm((DEPTH, D_MODEL, D_MODEL), D_MODEL)

    f_w1 = nrm((DEPTH, D_MODEL, D_FF), D_MODEL)
    f_w2 = nrm((DEPTH, D_FF, D_MODEL), D_FF)

    return {"x": x, "mem": mem, "norm_mix": norm_mix, "norm_xattn": norm_xattn,
            "norm_mem": norm_mem, "norm_ffn": norm_ffn, "norm_final": norm_final,
            "a_w_in": a_w_in, "a_lambda_re": a_lambda_re, "a_lambda_im": a_lambda_im,
            "a_log_dt": a_log_dt, "a_b_re": a_b_re, "a_b_im": a_b_im,
            "a_c_re": a_c_re, "a_c_im": a_c_im, "a_d": a_d,
            "a_w_glu": a_w_glu, "a_w_out": a_w_out,
            "b_w_in": b_w_in, "b_conv_w": b_conv_w, "b_w_out": b_w_out,
            "x_w_q": x_w_q, "x_w_kv": x_w_kv, "x_w_o": x_w_o,
            "f_w1": f_w1, "f_w2": f_w2}


def reference(x, mem, norm_mix, norm_xattn, norm_mem, norm_ffn, norm_final,
              a_w_in, a_lambda_re, a_lambda_im, a_log_dt, a_b_re, a_b_im,
              a_c_re, a_c_im, a_d, a_w_glu, a_w_out,
              b_w_in, b_conv_w, b_w_out,
              x_w_q, x_w_kv, x_w_o, f_w1, f_w2):
    h = x
    for i in range(DEPTH):
        hn = _rmsnorm(h, norm_mix[i])
        j = i // N_MIXERS
        if i % N_MIXERS == 0:
            mix = _s5_mixer(hn, a_w_in[j], a_lambda_re[j], a_lambda_im[j], a_log_dt[j],
                            a_b_re[j], a_b_im[j], a_c_re[j], a_c_im[j], a_d[j],
                            a_w_glu[j], a_w_out[j])
        else:
            mix = _short_conv_mixer(hn, b_w_in[j], b_conv_w[j], b_w_out[j])
        h = h + mix
        h = h + _memory_xattn(_rmsnorm(h, norm_xattn[i]), _rmsnorm(mem, norm_mem[i]),
                              x_w_q[i], x_w_kv[i], x_w_o[i])
        h = h + _sq_relu_mlp(_rmsnorm(h, norm_ffn[i]), f_w1[i], f_w2[i])
    return _rmsnorm(h, norm_final)
```

```cpp
#include <hip/hip_runtime.h>
#include <cstdio>
#include <cstdint>

#define LAS __attribute__((address_space(3)))
#define GAS __attribute__((address_space(1)))
typedef unsigned short bf16_t;
typedef short bf16x8 __attribute__((ext_vector_type(8)));
typedef float f32x4 __attribute__((ext_vector_type(4)));
typedef float f32x2 __attribute__((ext_vector_type(2)));
typedef unsigned u32x4 __attribute__((ext_vector_type(4)));
typedef unsigned u32x2 __attribute__((ext_vector_type(2)));

constexpr int T = 32768, D = 1024, FF = 4096, SEQ = 8192, NB = 4, MEMT = 1024, MEML = 256;
constexpr int NG = 64, CN = 32, NCH = T / CN, NCHB = SEQ / CN, KS1 = CN * 16, KS3 = CN * 16 + 256;
constexpr float EPS = 1e-6f;

namespace pg8 {
constexpr int BM = 256, BK = 64, HALF = 128, HTB = HALF * BK * 2, STAGE_BYTES = 8 * HTB, NXCD = 8, WGM = 8;
__host__ __device__ __forceinline__ int lds_byte(int r, int c) { const int st = (r >> 4) * 2 + (c >> 5), rr = r & 15, cc = c & 31, ob = rr * 64 + cc * 2; return st * 1024 + (ob ^ (((ob >> 9) & 1) << 5)); }
__host__ __device__ __forceinline__ void stage_rc(int b, int& R, int& C) { const int st = b / 1024, sb = b % 1024, swz = sb ^ (((sb >> 9) & 1) << 5); R = (st >> 1) * 16 + swz / 64; C = (st & 1) * 32 + (swz % 64) / 2; }
__host__ __device__ __forceinline__ int perm32(int rho) { const int n = rho >> 4, i = rho & 15; return 8 * (i >> 2) + 4 * n + (i & 3); }

struct Unit { int pm, pn; long aoff, boff; };
struct Gemm { const bf16_t* A; const bf16_t* Bt; int K; unsigned a_rs, a_c16, a_kstep, b_rs; };

template <class Map> struct Order {
    int nM, nN, nwg, G, c; Map mp;
    __device__ __forceinline__ void init(int nM_, int nN_, int G_, int c_, const Map& m) { nM = nM_; nN = nN_; nwg = nM * nN; G = G_; c = c_; mp = m; }
    __device__ __forceinline__ bool next(int i, Unit& u) const {
        const long L = (long)i * G + c; if (L >= nwg) return false;
        int wgid = (int)L; { const int q = nwg / NXCD, r = nwg % NXCD, xcd = wgid % NXCD, off = wgid / NXCD; wgid = (xcd < r ? xcd * (q + 1) : r * (q + 1) + (xcd - r) * q) + off; }
        const int nig = WGM * nN, gid = wgid / nig, fm = gid * WGM, gsz = (nM - fm) < WGM ? (nM - fm) : WGM;
        const int pm = fm + ((wgid % nig) % gsz), pn = (wgid % nig) / gsz;
        mp.map(pm, pn, u); return true;
    }
};
struct MapG { long a_t, b_t; int grp_m, nNb, a_mod;
    __device__ __forceinline__ void map(int pm, int pn, Unit& u) const { u.pm = pm; u.pn = pn; u.aoff = (long)(pm % a_mod) * a_t; u.boff = (long)((pm / grp_m) * nNb + pn) * b_t; } };

__device__ __forceinline__ unsigned cvt_pk_bf16(float lo, float hi) { unsigned r; asm volatile("v_cvt_pk_bf16_f32 %0, %1, %2" : "=v"(r) : "v"(lo), "v"(hi)); return r; }
__device__ __forceinline__ u32x4 pack8(const f32x4 a, const f32x4 b) { u32x4 w; w.x = cvt_pk_bf16(a[0], a[1]); w.y = cvt_pk_bf16(a[2], a[3]); w.z = cvt_pk_bf16(b[0], b[1]); w.w = cvt_pk_bf16(b[2], b[3]); return w; }
__device__ __forceinline__ void unpack8(const u32x4 w, f32x4& a, f32x4& b) {
    a[0] = __uint_as_float(w.x << 16); a[1] = __uint_as_float(w.x & 0xffff0000u); a[2] = __uint_as_float(w.y << 16); a[3] = __uint_as_float(w.y & 0xffff0000u);
    b[0] = __uint_as_float(w.z << 16); b[1] = __uint_as_float(w.z & 0xffff0000u); b[2] = __uint_as_float(w.w << 16); b[3] = __uint_as_float(w.w & 0xffff0000u); }
__device__ __forceinline__ float row_rinv(const float* ssqp, int row) {
    const f32x4* p = (const f32x4*)(ssqp + (size_t)row * 16); const f32x4 a = p[0], b = p[1], c = p[2], d = p[3];
    const f32x4 s = (a + b) + (c + d); return __builtin_amdgcn_rsqf(((s[0] + s[1]) + (s[2] + s[3])) * (1.0f / 1024.0f) + EPS); }

#define EPI_ROWS_BEGIN _Pragma("unroll") for (int ai = 0; ai < 2; ++ai) _Pragma("unroll") for (int m = 0; m < 4; ++m) { const int rt = ai * 128 + wr * 64 + m * 16 + fr; const int row = u.pm * 256 + rt; (void)row;
#define EPI_ROWS_END }
#define EPI_COLS_BEGIN _Pragma("unroll") for (int bj = 0; bj < 2; ++bj) { const int ct = bj * 128 + wc * 32 + 8 * fq; (void)ct;
#define EPI_COLS_END }

struct EpiBf16Plain {
    bf16_t* O; int ldc;
    __device__ __forceinline__ void operator()(f32x4 (&acc)[2][2][4][2], const Unit& u, int wr, int wc, int fr, int fq) const {
        EPI_ROWS_BEGIN bf16_t* rowp = O + (size_t)row * ldc + u.pn * 256;
        EPI_COLS_BEGIN *(u32x4*)(rowp + ct) = pack8(acc[ai][bj][m][0], acc[ai][bj][m][1]); EPI_COLS_END
        EPI_ROWS_END }
};
struct EpiF32Plain {
    float* O; int ldc;
    __device__ __forceinline__ void operator()(f32x4 (&acc)[2][2][4][2], const Unit& u, int wr, int wc, int fr, int fq) const {
        EPI_ROWS_BEGIN float* rowp = O + (size_t)row * ldc + u.pn * 256;
        EPI_COLS_BEGIN *(f32x4*)(rowp + ct) = acc[ai][bj][m][0]; *(f32x4*)(rowp + ct + 4) = acc[ai][bj][m][1]; EPI_COLS_END
        EPI_ROWS_END }
};
struct EpiU {
    bf16_t* UX; const float* ssqp;
    __device__ __forceinline__ void operator()(f32x4 (&acc)[2][2][4][2], const Unit& u, int wr, int wc, int fr, int fq) const {
        EPI_ROWS_BEGIN const float ri = row_rinv(ssqp, row); const int ch = row >> 5, tau = row & 31;
        EPI_COLS_BEGIN const int col = u.pn * 256 + ct, g = col >> 4, h0 = col & 15;
            *(u32x4*)(UX + ((size_t)g * NCH + ch) * KS3 + tau * 16 + h0) = pack8(acc[ai][bj][m][0] * ri, acc[ai][bj][m][1] * ri); EPI_COLS_END
        EPI_ROWS_END }
};
__device__ __forceinline__ float gelu_tanh(float x) {
    const float t = x * (0.7978845608f + 0.0356774081f * x * x);
    return x * __builtin_amdgcn_rcpf(1.0f + __builtin_amdgcn_exp2f(-2.8853900818f * t)); }
__device__ __forceinline__ float sigmoidf_(float x) { return __builtin_amdgcn_rcpf(1.0f + __builtin_amdgcn_exp2f(-1.4426950409f * x)); }
struct EpiGelu {
    bf16_t* O;
    __device__ __forceinline__ void operator()(f32x4 (&acc)[2][2][4][2], const Unit& u, int wr, int wc, int fr, int fq) const {
        EPI_ROWS_BEGIN bf16_t* rowp = O + (size_t)row * 512 + u.pn * 256;
        EPI_COLS_BEGIN f32x4 a = acc[ai][bj][m][0], b = acc[ai][bj][m][1];
#pragma unroll
            for (int e = 0; e < 4; ++e) { a[e] = gelu_tanh(a[e]); b[e] = gelu_tanh(b[e]); }
            *(u32x4*)(rowp + ct) = pack8(a, b); EPI_COLS_END
        EPI_ROWS_END }
};
struct EpiGlu {
    const bf16_t* Zgm; bf16_t* Z2;
    __device__ __forceinline__ void operator()(f32x4 (&acc)[2][2][4][2], const Unit& u, int wr, int wc, int fr, int fq) const {
        EPI_ROWS_BEGIN
        EPI_COLS_BEGIN const int col = u.pn * 256 + ct; const u32x4 zw = *(const u32x4*)(Zgm + ((size_t)(col >> 4) * T + row) * 16 + (col & 15));
            f32x4 za, zb; unpack8(zw, za, zb); f32x4 a = acc[ai][bj][m][0], b = acc[ai][bj][m][1];
#pragma unroll
            for (int e = 0; e < 4; ++e) { a[e] = za[e] * sigmoidf_(a[e]); b[e] = zb[e] * sigmoidf_(b[e]); }
            *(u32x4*)(Z2 + (size_t)row * D + col) = pack8(a, b); EPI_COLS_END
        EPI_ROWS_END }
};
struct EpiRes {
    const float* base; float* out; bf16_t* Hb; float* ssqp;
    __device__ __forceinline__ void operator()(f32x4 (&acc)[2][2][4][2], const Unit& u, int wr, int wc, int fr, int fq) const {
        EPI_ROWS_BEGIN float ss = 0.f;
        EPI_COLS_BEGIN const size_t off = (size_t)row * D + u.pn * 256 + ct;
            const f32x4 a = *(const f32x4*)(base + off) + acc[ai][bj][m][0], b = *(const f32x4*)(base + off + 4) + acc[ai][bj][m][1];
            *(f32x4*)(out + off) = a; *(f32x4*)(out + off + 4) = b; *(u32x4*)(Hb + off) = pack8(a, b);
            ss += (a[0] * a[0] + a[1] * a[1]) + (a[2] * a[2] + a[3] * a[3]) + (b[0] * b[0] + b[1] * b[1]) + (b[2] * b[2] + b[3] * b[3]); EPI_COLS_END
            ss += __shfl_xor(ss, 16); ss += __shfl_xor(ss, 32);
            if (fq == 0) ssqp[(size_t)row * 16 + u.pn * 4 + wc] = ss;
            if (m & 1) asm volatile("" ::: "memory");
        EPI_ROWS_END }
};
struct EpiRelu2 {
    bf16_t* O; const float* ssqp;
    __device__ __forceinline__ void operator()(f32x4 (&acc)[2][2][4][2], const Unit& u, int wr, int wc, int fr, int fq) const {
        EPI_ROWS_BEGIN const float ri = row_rinv(ssqp, row); bf16_t* rowp = O + (size_t)row * FF + u.pn * 256;
        EPI_COLS_BEGIN f32x4 a = acc[ai][bj][m][0] * ri, b = acc[ai][bj][m][1] * ri;
#pragma unroll
            for (int e = 0; e < 4; ++e) { a[e] = fmaxf(a[e], 0.f); a[e] *= a[e]; b[e] = fmaxf(b[e], 0.f); b[e] *= b[e]; }
            *(u32x4*)(rowp + ct) = pack8(a, b); EPI_COLS_END
        EPI_ROWS_END }
};
struct EpiBCV {
    bf16_t* Zbv; bf16_t* Cg; const float* ssqp;
    __device__ __forceinline__ void operator()(f32x4 (&acc)[2][2][4][2], const Unit& u, int wr, int wc, int fr, int fq) const {
        if (u.pn < 8) {
            EPI_ROWS_BEGIN const float ri = row_rinv(ssqp, row), r2 = ri * ri;
                *(u32x4*)(Zbv + (size_t)row * D + u.pn * 128 + wc * 32 + 8 * fq) = pack8(acc[ai][0][m][0] * acc[ai][1][m][0] * r2, acc[ai][0][m][1] * acc[ai][1][m][1] * r2);
            EPI_ROWS_END
        } else {
            EPI_ROWS_BEGIN const float ri = row_rinv(ssqp, row); bf16_t* rowp = Cg + (size_t)row * D + (u.pn - 8) * 256;
            EPI_COLS_BEGIN *(u32x4*)(rowp + ct) = pack8(acc[ai][bj][m][0] * ri, acc[ai][bj][m][1] * ri); EPI_COLS_END
            EPI_ROWS_END
        }
    }
};
struct EpiSoftmax {
    bf16_t* P; const float* ssqp; LAS f32x2* xch;
    __device__ __forceinline__ void operator()(f32x4 (&acc)[2][2][4][2], const Unit& u, int wr, int wc, int fr, int fq) const {
        float mw[2][4];
        EPI_ROWS_BEGIN const float ri = row_rinv(ssqp, row) * 1.4426950409f; float mx = -3.0e38f;
        EPI_COLS_BEGIN
#pragma unroll
            for (int n = 0; n < 2; ++n) { acc[ai][bj][m][n] = acc[ai][bj][m][n] * ri; const f32x4 v = acc[ai][bj][m][n]; mx = fmaxf(mx, fmaxf(fmaxf(v[0], v[1]), fmaxf(v[2], v[3]))); } EPI_COLS_END
            mx = fmaxf(mx, __shfl_xor(mx, 16)); mx = fmaxf(mx, __shfl_xor(mx, 32)); float sm = 0.f;
        EPI_COLS_BEGIN
#pragma unroll
            for (int n = 0; n < 2; ++n) { f32x4 v = acc[ai][bj][m][n];
#pragma unroll
                for (int e = 0; e < 4; ++e) { v[e] = __builtin_amdgcn_exp2f(v[e] - mx); sm += v[e]; } acc[ai][bj][m][n] = v; } EPI_COLS_END
            sm += __shfl_xor(sm, 16); sm += __shfl_xor(sm, 32); mw[ai][m] = mx;
            if (fq == 0) xch[rt * 4 + wc] = (f32x2){mx, sm};
        EPI_ROWS_END
        asm volatile("s_waitcnt lgkmcnt(0)" ::: "memory"); __builtin_amdgcn_s_barrier(); asm volatile("" ::: "memory");
        EPI_ROWS_BEGIN const f32x2 p0 = xch[rt * 4 + 0], p1 = xch[rt * 4 + 1], p2 = xch[rt * 4 + 2], p3 = xch[rt * 4 + 3];
            const float M = fmaxf(fmaxf(p0.x, p1.x), fmaxf(p2.x, p3.x));
            const float Ls = (p0.y * __builtin_amdgcn_exp2f(p0.x - M) + p1.y * __builtin_amdgcn_exp2f(p1.x - M)) + (p2.y * __builtin_amdgcn_exp2f(p2.x - M) + p3.y * __builtin_amdgcn_exp2f(p3.x - M));
            const float f = __builtin_amdgcn_exp2f(mw[ai][m] - M) * __builtin_amdgcn_rcpf(Ls); bf16_t* rowp = P + (size_t)row * D + u.pn * 256;
        EPI_COLS_BEGIN *(u32x4*)(rowp + ct) = pack8(acc[ai][bj][m][0] * f, acc[ai][bj][m][1] * f); EPI_COLS_END
        EPI_ROWS_END
        asm volatile("s_waitcnt lgkmcnt(0)" ::: "memory"); __builtin_amdgcn_s_barrier(); asm volatile("" ::: "memory");
    }
};

template <class Epi, class Sched>
__device__ __forceinline__ void gemm_phase(LAS unsigned char* lds, const Gemm g, const Sched& S, const Epi& E) {
    int tid = threadIdx.x; asm volatile("" : "+v"(tid));
    const int wid = __builtin_amdgcn_readfirstlane(tid >> 6), lane = tid & 63, wr = wid >> 2, wc = wid & 3, fr = lane & 15, fq = lane >> 4;
    const int nt = g.K / BK;
    unsigned voffA[2], voffB[2];
#pragma unroll
    for (int i = 0; i < 2; ++i) { int R, C; stage_rc(tid * 16 + i * 8192, R, C); const int Rb = (R & ~31) + perm32(R & 31);
        voffA[i] = (unsigned)R * g.a_rs + (unsigned)(C >> 4) * g.a_c16 + (unsigned)(C & 15) * 2u; voffB[i] = (unsigned)Rb * g.b_rs + (unsigned)C * 2u; }
    const size_t kstepA = (size_t)g.a_kstep, kstepB = (size_t)(BK * 2);
    const size_t hstepA = (size_t)HALF * g.a_rs, hstepB = (size_t)HALF * g.b_rs;
    const unsigned ldsw = (unsigned)wid * 1024u;
    const int aoff = lds_byte(wr * 64 + fr, fq * 8), boff = lds_byte(wc * 32 + fr, fq * 8);
#define PG8_SA(b, h) (((b) * 2 + (h)) * HTB)
#define PG8_SB(b, h) ((4 + (b) * 2 + (h)) * HTB)
#define PG8_STAGE(bufoff, gbase, voff) do { _Pragma("unroll") for (int _i = 0; _i < 2; ++_i) \
        __builtin_amdgcn_global_load_lds((const unsigned*)((const char*)(gbase) + (voff)[_i]), (LAS unsigned*)(lds + (bufoff) + ldsw + _i * 8192), 16, 0, 0); } while (0)
#define PG8_LDA(dst, b, h) do { _Pragma("unroll") for (int m = 0; m < 4; ++m) _Pragma("unroll") for (int k = 0; k < 2; ++k) dst[m][k] = *(const LAS bf16x8*)(lds + PG8_SA(b, h) + aoff + m * 2048 + k * 1024); } while (0)
#define PG8_LDB(dst, b, h) do { _Pragma("unroll") for (int n = 0; n < 2; ++n) _Pragma("unroll") for (int k = 0; k < 2; ++k) dst[n][k] = *(const LAS bf16x8*)(lds + PG8_SB(b, h) + boff + n * 2048 + k * 1024); } while (0)
#define PG8_MMA(ai, bj, At, Bt) do { __builtin_amdgcn_s_setprio(1); _Pragma("unroll") for (int m = 0; m < 4; ++m) _Pragma("unroll") for (int n = 0; n < 2; ++n) _Pragma("unroll") for (int k = 0; k < 2; ++k) \
        acc[ai][bj][m][n] = __builtin_amdgcn_mfma_f32_16x16x32_bf16(Bt[n][k], At[m][k], acc[ai][bj][m][n], 0, 0, 0); __builtin_amdgcn_s_setprio(0); } while (0)
#define PG8_WAIT_V(n) asm volatile("s_waitcnt vmcnt(" #n ")" ::: "memory")
#define PG8_WAIT_L(n) asm volatile("s_waitcnt lgkmcnt(" #n ")" ::: "memory")
#define PG8_BAR __builtin_amdgcn_s_barrier()
#define PG8_SCHED __builtin_amdgcn_sched_barrier(0)
    Unit cur, nxt; int ui = 0;
    if (!S.next(0, cur)) return;
    f32x4 acc[2][2][4][2];
#pragma unroll
    for (int a = 0; a < 2; ++a)
#pragma unroll
        for (int b = 0; b < 2; ++b)
#pragma unroll
            for (int m = 0; m < 4; ++m)
#pragma unroll
                for (int n = 0; n < 2; ++n) acc[a][b][m][n] = (f32x4){0.f, 0.f, 0.f, 0.f};
    bf16x8 At[4][2], B0[2][2], B1[2][2];
    const char* cA = (const char*)g.A + cur.aoff; const char* cB = (const char*)g.Bt + cur.boff;
    PG8_STAGE(PG8_SB(0, 0), cB, voffB); PG8_STAGE(PG8_SB(0, 1), cB + hstepB, voffB); PG8_STAGE(PG8_SA(0, 0), cA, voffA); PG8_STAGE(PG8_SA(0, 1), cA + hstepA, voffA);
    if (wr == 1) PG8_BAR;
    PG8_WAIT_V(2); PG8_BAR;
    PG8_STAGE(PG8_SB(1, 0), cB + kstepB, voffB); PG8_STAGE(PG8_SA(1, 0), cA + kstepA, voffA); PG8_STAGE(PG8_SB(1, 1), cB + hstepB + kstepB, voffB);
    PG8_WAIT_V(6); PG8_BAR;
#pragma nounroll
    for (;;) {
        const bool has_next = S.next(ui + 1, nxt);
        const char* nA = has_next ? (const char*)g.A + nxt.aoff : cA; const char* nB = has_next ? (const char*)g.Bt + nxt.boff : cB;
#pragma nounroll
        for (int t = 0; t < nt; t += 2) {
            const bool last = (t == nt - 2);
            const char* a1 = cA + (size_t)(t + 1) * kstepA;
            const char* a2 = last ? nA : cA + (size_t)(t + 2) * kstepA; const char* b2 = last ? nB : cB + (size_t)(t + 2) * kstepB;
            const char* a3 = a2 + kstepA; const char* b3 = b2 + kstepB;
            PG8_LDB(B0, 0, 0); PG8_LDB(B1, 0, 1); PG8_SCHED; PG8_LDA(At, 0, 0); PG8_STAGE(PG8_SA(1, 1), a1 + hstepA, voffA);
            PG8_WAIT_V(8); PG8_WAIT_L(0); PG8_BAR; PG8_MMA(0, 0, At, B0); PG8_MMA(0, 1, At, B1); PG8_BAR; PG8_SCHED;
            PG8_LDA(At, 0, 1); PG8_STAGE(PG8_SB(0, 0), b2, voffB); PG8_STAGE(PG8_SB(0, 1), b2 + hstepB, voffB); PG8_STAGE(PG8_SA(0, 0), a2, voffA);
            PG8_WAIT_V(8); PG8_WAIT_L(0); PG8_BAR; PG8_MMA(1, 0, At, B0); PG8_MMA(1, 1, At, B1); PG8_BAR; PG8_SCHED;
            PG8_LDB(B0, 1, 0); PG8_LDB(B1, 1, 1); PG8_SCHED; PG8_LDA(At, 1, 0); PG8_STAGE(PG8_SA(0, 1), a2 + hstepA, voffA);
            PG8_WAIT_V(8); PG8_WAIT_L(0); PG8_BAR; PG8_MMA(0, 0, At, B0); PG8_MMA(0, 1, At, B1); PG8_BAR; PG8_SCHED;
            PG8_LDA(At, 1, 1); PG8_STAGE(PG8_SB(1, 0), b3, voffB); PG8_STAGE(PG8_SB(1, 1), b3 + hstepB, voffB); PG8_STAGE(PG8_SA(1, 0), a3, voffA);
            PG8_WAIT_V(8); PG8_WAIT_L(0); PG8_BAR; PG8_MMA(1, 0, At, B0); PG8_MMA(1, 1, At, B1); PG8_BAR; PG8_SCHED;
        }
        if (wr == 0) PG8_BAR;
        E(acc, cur, wr, wc, fr, fq);
        if (!has_next) break;
#pragma unroll
        for (int a = 0; a < 2; ++a)
#pragma unroll
            for (int b = 0; b < 2; ++b)
#pragma unroll
                for (int m = 0; m < 4; ++m)
#pragma unroll
                    for (int n = 0; n < 2; ++n) acc[a][b][m][n] = (f32x4){0.f, 0.f, 0.f, 0.f};
        cur = nxt; cA = nA; cB = nB; ++ui;
        if (wr == 1) PG8_BAR;
    }
    PG8_WAIT_V(0);
    PG8_BAR;
#undef PG8_SA
#undef PG8_SB
#undef PG8_STAGE
#undef PG8_LDA
#undef PG8_LDB
#undef PG8_MMA
#undef PG8_WAIT_V
#undef PG8_WAIT_L
#undef PG8_BAR
#undef PG8_SCHED
}
}

constexpr size_t MiB = 1u << 20;
constexpr size_t WS_CTL = 0, CTL_ZERO_BYTES = 64 * 1024;
constexpr size_t WS_WINT = 1 * MiB, WS_WGLUT = 3 * MiB, WS_WOUTT = 5 * MiB, WS_BINT = 7 * MiB, WS_BOUTT = 13 * MiB, WS_WQN = 15 * MiB, WS_WOT = 19 * MiB,
                 WS_WKVT = 23 * MiB, WS_W1T = 31 * MiB, WS_W2T = 47 * MiB;
constexpr size_t WS_MEMN = 63 * MiB, WS_KV = 65 * MiB, WS_WEFFT = 73 * MiB, WS_VWT = 89 * MiB, WS_HB = 105 * MiB, WS_SSQP = 169 * MiB;
constexpr size_t WS_WS = 171 * MiB, WS_W3 = 187 * MiB, WS_UX = 235 * MiB, WS_S = 331 * MiB, WS_ZGM = 395 * MiB;
constexpr size_t WS_Z2 = 235 * MiB, WS_P = 171 * MiB, WS_AFF = 235 * MiB, WS_ZBV = 235 * MiB, WS_CG = 299 * MiB, WS_ZC = 363 * MiB, WS_END = 491 * MiB;
constexpr int CW_BAR = 4096;
constexpr int RING_BYTES = 131072, XCH_OFF = RING_BYTES, MISC_OFF = RING_BYTES + 8192 + 1024, LDS_BYTES = 147456;
constexpr int NWAVES = 8;

#define RLX_AGENT __ATOMIC_RELAXED, __HIP_MEMORY_SCOPE_AGENT
#define LDS_WAIT() asm volatile("s_waitcnt lgkmcnt(0)" ::: "memory")
#define VM_WAIT() asm volatile("s_waitcnt vmcnt(0)" ::: "memory")

#define XB_TMO      128
#define XB_XCNT(j)  (256  + 64 * (j))
#define XB_XSUB(j)  (1280 + 64 * (j))
#define XB_XGEN(j)  (2304 + 64 * (j))
#define XB_TOP      3328
#define XB_TOPGEN   3392
#define XCD_BAR_WORDS 3456
#define XB_SPIN_CAP (1u << 20)
__device__ __forceinline__ unsigned xb_ld(unsigned* p)              { return __hip_atomic_load(p, __ATOMIC_RELAXED, __HIP_MEMORY_SCOPE_AGENT); }
__device__ __forceinline__ unsigned xb_add(unsigned* p, unsigned v) { return __hip_atomic_fetch_add(p, v, __ATOMIC_RELAXED, __HIP_MEMORY_SCOPE_AGENT); }
__device__ __forceinline__ unsigned xb_xcc_id() { return (unsigned)__builtin_amdgcn_s_getreg((3 << 11) | 20) & 0xFu; }
#define XB_SPIN(cond, bar) do { unsigned _sp = 0; while (cond) { __builtin_amdgcn_s_sleep(1); \
    if ((++_sp & 255u) == 0u) { if (xb_ld(&(bar)[XB_TMO])) break; if (_sp > XB_SPIN_CAP) { atomicAdd(&(bar)[XB_TMO], 1u); break; } } } } while (0)
struct XcdBarrier { unsigned* bar; unsigned x; volatile LAS unsigned* st; };
__device__ __forceinline__ XcdBarrier xcd_barrier_post(unsigned* bar, volatile LAS unsigned* st) {
    XcdBarrier b; b.bar = bar; b.x = xb_xcc_id(); b.st = st;
    if (threadIdx.x == 0) (void)xb_add(&bar[XB_XCNT(b.x)], 1u);
    return b;
}
__device__ __forceinline__ void xcd_barrier_complete(unsigned* bar, unsigned x, unsigned& nloc, unsigned& nx) {
    const unsigned G = gridDim.x * gridDim.y * gridDim.z;
    unsigned sum, cnt, mine, sp = 0u;
    for (;;) {
        sum = 0u; cnt = 0u; mine = 0u;
#pragma unroll
        for (unsigned j = 0; j < 16; ++j) { const unsigned c = xb_ld(&bar[XB_XCNT(j)]); sum += c; cnt += (c > 0u) ? 1u : 0u; mine = (j == x) ? c : mine; }
        if (sum == G) break;
        __builtin_amdgcn_s_sleep(1);
        if ((++sp & 255u) == 0u) { if (xb_ld(&bar[XB_TMO])) break; if (sp > XB_SPIN_CAP) { atomicAdd(&bar[XB_TMO], 1u); break; } }
    }
    nloc = mine > 0u ? mine : 1u; nx = cnt > 0u ? cnt : 1u;
}
__device__ __forceinline__ void xcd_barrier(const XcdBarrier& b) {
    asm volatile("s_waitcnt vmcnt(0)" ::: "memory");
    __syncthreads();
    if (threadIdx.x == 0) {
        unsigned* bar = b.bar;
        __builtin_amdgcn_s_waitcnt(0);
        unsigned nloc = b.st[0], nx = b.st[1];
        if (nloc == 0u) { xcd_barrier_complete(bar, b.x, nloc, nx); b.st[0] = nloc; b.st[1] = nx; }
        const unsigned old = xb_add(&bar[XB_XSUB(b.x)], 1u);
        const unsigned gen = old / nloc;
        if (old + 1u == (gen + 1u) * nloc) {
            __builtin_amdgcn_fence(__ATOMIC_RELEASE, "agent");
            asm volatile("s_waitcnt vmcnt(0)" ::: "memory");
            const unsigned og = xb_add(&bar[XB_TOP], 1u);
            const unsigned tg = og / nx;
            if (og + 1u == (tg + 1u) * nx) xb_add(&bar[XB_TOPGEN], 1u);
            else XB_SPIN(xb_ld(&bar[XB_TOPGEN]) == tg, bar);
            __builtin_amdgcn_fence(__ATOMIC_ACQUIRE, "agent");
            xb_add(&bar[XB_XGEN(b.x)], 1u);
            asm volatile("s_waitcnt vmcnt(0)" ::: "memory");
        } else {
            XB_SPIN(xb_ld(&bar[XB_XGEN(b.x)]) == gen, bar);
            __builtin_amdgcn_fence(__ATOMIC_ACQUIRE, "agent");
            asm volatile("s_waitcnt vmcnt(0)" ::: "memory");
        }
    }
    __syncthreads();
}

__device__ __forceinline__ float wave_sum(float v) {
#pragma unroll
    for (int o = 1; o < 64; o <<= 1) v += __shfl_xor(v, o);
    return v;
}
using pg8::cvt_pk_bf16;
__device__ __forceinline__ void transpose_item(const float* W, int ldw, int k0, int n0, const float* gain, bf16_t* WT, int K, int drow0, LAS float* scr, int lane) {
#pragma unroll 8
    for (int i = 0; i < 32; ++i) { const int kk = 2 * i + (lane >> 5); float v = W[(size_t)(k0 + kk) * ldw + n0 + (lane & 31)]; if (gain) v *= gain[k0 + kk]; scr[kk * 33 + (lane & 31)] = v; }
    LDS_WAIT(); asm volatile("" ::: "memory");
    const int c = lane & 7;
#pragma unroll
    for (int j = 0; j < 4; ++j) { const int n = (lane >> 3) + 8 * j; const LAS float* s = scr + (8 * c) * 33 + n;
        u32x4 o; o.x = cvt_pk_bf16(s[0 * 33], s[1 * 33]); o.y = cvt_pk_bf16(s[2 * 33], s[3 * 33]); o.z = cvt_pk_bf16(s[4 * 33], s[5 * 33]); o.w = cvt_pk_bf16(s[6 * 33], s[7 * 33]);
        *(u32x4*)(WT + (size_t)(drow0 + n) * K + k0 + 8 * c) = o; }
    LDS_WAIT(); asm volatile("" ::: "memory");
}
__device__ __forceinline__ bool transpose_job(int& r, const float* W, int K, int N, const float* gain, bf16_t* WT, int kind, LAS float* scr, int lane) {
    const int nblk = N / 32, items = (K / 64) * nblk;
    if (r >= items) { r -= items; return false; }
    const int kb = r / nblk, nb = r % nblk, n0 = nb * 32; int drow0 = n0;
    if (kind == 1) { if (n0 < 1024) drow0 = 256 * (n0 >> 7) + (n0 & 127); else if (n0 < 2048) drow0 = 2048 + (n0 - 1024); else drow0 = 256 * ((n0 - 2048) >> 7) + 128 + ((n0 - 2048) & 127); }
    transpose_item(W, N, kb * 64, n0, gain, WT, K, drow0, scr, lane); return true;
}

typedef f32x2 cf;
__device__ __forceinline__ cf mkcf(float a, float b) { cf r; r.x = a; r.y = b; return r; }
__device__ __forceinline__ cf cmul(cf a, cf b) { return mkcf(a.x * b.x - a.y * b.y, a.x * b.y + a.y * b.x); }

__device__ __forceinline__ void ssm_tables(LAS unsigned char* lds, int g, int q, const float* lre, const float* lim, const float* logdt, const float* bre, const float* bim,
                                           const float* cre, const float* cim, const float* dd, bf16_t* WS, bf16_t* W3) {
    LAS cf* apow = (LAS cf*)lds; LAS cf* Bb = apow + 2 * 33 * 64; LAS cf* Cc = Bb + 2 * 64 * 16; LAS float* Kt = (LAS float*)(Cc + 2 * 16 * 64);
    const int tid = threadIdx.x;
    if (tid < 128) {
        const int r = tid >> 6, p = tid & 63; const int gi = (r * 64 + g) * 64 + p;
        const float lr = lre[gi], li = lim[gi], dt = expf(logdt[r * 64 + g]); const float x = lr * dt, y = li * dt;
        for (int k = 0; k <= 32; ++k) { const float mag = expf((float)k * x), ang = (float)k * y; apow[(r * 33 + k) * 64 + p] = mkcf(mag * cosf(ang), mag * sinf(ang)); }
        const float sh = sinf(0.5f * y); const cf am1 = mkcf(expm1f(x) * cosf(y) - 2.0f * sh * sh, expf(x) * sinf(y));
        const float den = 1.0f / (lr * lr + li * li); const cf coef = mkcf((am1.x * lr + am1.y * li) * den, (am1.y * lr - am1.x * li) * den);
        for (int h = 0; h < 16; ++h) { const cf b = mkcf(bre[(size_t)gi * 16 + h], bim[(size_t)gi * 16 + h]); Bb[(r * 64 + p) * 16 + h] = cmul(coef, b); }
    }
    for (int j = 0; j < 4; ++j) { const int idx = tid + 512 * j, r = idx >> 10, h = (idx >> 6) & 15, p = idx & 63; const size_t gi = ((size_t)(r * 64 + g) * 16 + h) * 64 + p; Cc[idx] = mkcf(cre[gi], cim[gi]); }
    __syncthreads();
    {
        const int r = tid >> 8, h = (tid >> 4) & 15, hp = tid & 15; float acc[32];
#pragma unroll
        for (int k = 0; k < 32; ++k) acc[k] = 0.f;
        for (int p = 0; p < 64; ++p) { const cf cb = cmul(Cc[(r * 16 + h) * 64 + p], Bb[(r * 64 + p) * 16 + hp]);
#pragma unroll
            for (int k = 0; k < 32; ++k) { const cf ap = apow[(r * 33 + k) * 64 + p]; acc[k] += cb.x * ap.x - cb.y * ap.y; } }
#pragma unroll
        for (int k = 0; k < 32; ++k) Kt[(r * 32 + k) * 256 + h * 16 + hp] = acc[k];
    }
    __syncthreads();
    {
        const int r = q >> 1, im = q & 1;
        for (int j = 0; j < 8; ++j) { const int idx = tid + 512 * j, p = idx >> 6, kc = idx & 63, s = kc >> 1, h0 = (kc & 1) * 8, e = r == 0 ? 31 - s : s;
            const cf ap = apow[(r * 33 + e) * 64 + p]; float v[8];
#pragma unroll
            for (int i = 0; i < 8; ++i) { const cf z = cmul(ap, Bb[(r * 64 + p) * 16 + h0 + i]); v[i] = im ? z.y : z.x; }
            u32x4 o; o.x = cvt_pk_bf16(v[0], v[1]); o.y = cvt_pk_bf16(v[2], v[3]); o.z = cvt_pk_bf16(v[4], v[5]); o.w = cvt_pk_bf16(v[6], v[7]);
            *(u32x4*)(WS + ((size_t)(g * 256 + 64 * q + p) * KS1 + kc * 8)) = o; }
    }
    {
        for (int j = 0; j < 24; ++j) { const int idx = tid + 512 * j, lrow = idx / 96, kc = idx % 96, n = 128 * q + lrow, tau = n >> 4, h = n & 15, k0 = kc * 8; float v[8];
            if (k0 < 512) { const int s = kc >> 1, h0 = (kc & 1) * 8;
#pragma unroll
                for (int i = 0; i < 8; ++i) { const int hp = h0 + i; float t = 0.f; if (s <= tau) t += Kt[(tau - s) * 256 + h * 16 + hp]; if (s >= tau) t += Kt[(32 + s - tau) * 256 + h * 16 + hp];
                    if (s == tau && h == hp) t += dd[g * 16 + h]; v[i] = t; }
            } else { const int r = k0 >= 640 ? 1 : 0, rel = k0 - (r ? 640 : 512), im = rel >> 6, p0 = rel & 63, e = r ? 32 - tau : tau + 1;
#pragma unroll
                for (int i = 0; i < 8; ++i) { const cf z = cmul(Cc[(r * 16 + h) * 64 + p0 + i], apow[(r * 33 + e) * 64 + p0 + i]); v[i] = im ? -z.y : z.x; } }
            u32x4 o; o.x = cvt_pk_bf16(v[0], v[1]); o.y = cvt_pk_bf16(v[2], v[3]); o.z = cvt_pk_bf16(v[4], v[5]); o.w = cvt_pk_bf16(v[6], v[7]);
            *(u32x4*)(W3 + ((size_t)(g * 512 + n) * KS3 + k0)) = o; }
    }
    __syncthreads();
}

struct Args { const float* in[26]; float* out; unsigned char* ws; int ph_lo, ph_hi, li, pad; };
constexpr int N_PHASES = 19;
#ifndef MK_N_LAUNCHES
#define MK_N_LAUNCHES 19
#endif

__global__ void __launch_bounds__(NWAVES * 64, 2) trunk_fwd(Args args) {
    extern __shared__ __attribute__((aligned(16))) unsigned char lds_raw[];
    LAS unsigned char* lds = (LAS unsigned char*)lds_raw;
    volatile LAS unsigned* MISC = (volatile LAS unsigned*)(lds + MISC_OFF);
    const int G = gridDim.x, bx = blockIdx.x, vcu = (G % 8 == 0) ? (bx % 8) * (G / 8) + bx / 8 : bx, NGW = G * NWAVES;
#define PHASE_IDS int tid = threadIdx.x; asm volatile("" : "+v"(tid)); const int lane = tid & 63, wave = __builtin_amdgcn_readfirstlane(tid >> 6), gw = vcu * NWAVES + wave; (void)lane; (void)gw;
    unsigned char* ws = args.ws;
    unsigned* ctl = (unsigned*)(ws + WS_CTL);
    if (threadIdx.x < 64) MISC[threadIdx.x] = 0u;
    __syncthreads();
    XcdBarrier bar; bar.bar = ctl + CW_BAR; bar.x = 0; bar.st = nullptr;
    if (MK_N_LAUNCHES == 1) bar = xcd_barrier_post(ctl + CW_BAR, MISC + 8);
    const int lo = args.ph_lo, hi = args.ph_hi;
#ifndef PH_MASK
#define PH_MASK 0xFFFFFFFFu
#endif
#define IN(k) (((PH_MASK >> (((k) >= 14 && (k) <= 17) ? (k) - 7 : (k))) & 1u) && lo <= (k) && (k) < hi)
#define SEAM(k) do { if (lo <= (k) && (k) + 1 < hi) xcd_barrier(bar); } while (0)

    const float* x = args.in[0]; const float* mem = args.in[1]; const float* norm_mix = args.in[2]; const float* norm_xattn = args.in[3]; const float* norm_mem = args.in[4];
    const float* norm_ffn = args.in[5]; const float* norm_final = args.in[6];
    float* H = args.out;
    bf16_t* WinT = (bf16_t*)(ws + WS_WINT); bf16_t* WgluT = (bf16_t*)(ws + WS_WGLUT); bf16_t* WoutT = (bf16_t*)(ws + WS_WOUTT); bf16_t* BinT = (bf16_t*)(ws + WS_BINT); bf16_t* BoutT = (bf16_t*)(ws + WS_BOUTT);
    bf16_t* WqN = (bf16_t*)(ws + WS_WQN); bf16_t* WoT = (bf16_t*)(ws + WS_WOT); bf16_t* WkvT = (bf16_t*)(ws + WS_WKVT); bf16_t* W1T = (bf16_t*)(ws + WS_W1T); bf16_t* W2T = (bf16_t*)(ws + WS_W2T);
    bf16_t* memn = (bf16_t*)(ws + WS_MEMN); bf16_t* KV = (bf16_t*)(ws + WS_KV); bf16_t* WeffT = (bf16_t*)(ws + WS_WEFFT); bf16_t* VWT = (bf16_t*)(ws + WS_VWT);
    bf16_t* Hb = (bf16_t*)(ws + WS_HB); float* ssqp = (float*)(ws + WS_SSQP);
    bf16_t* WSs = (bf16_t*)(ws + WS_WS); bf16_t* W3 = (bf16_t*)(ws + WS_W3); bf16_t* UX = (bf16_t*)(ws + WS_UX); float* Ssum = (float*)(ws + WS_S); bf16_t* Zgm = (bf16_t*)(ws + WS_ZGM);
    bf16_t* Z2 = (bf16_t*)(ws + WS_Z2); bf16_t* Pm = (bf16_t*)(ws + WS_P); bf16_t* Aff = (bf16_t*)(ws + WS_AFF); bf16_t* Zbv = (bf16_t*)(ws + WS_ZBV); bf16_t* Cg = (bf16_t*)(ws + WS_CG); bf16_t* Zc = (bf16_t*)(ws + WS_ZC);
    constexpr int BIG = 1 << 30;
    constexpr long TS2K = 256L * 2048;

    if (IN(0)) {
        PHASE_IDS
        for (int it = vcu; it < 4 * NG; it += G)
            ssm_tables(lds, it >> 2, it & 3, args.in[8], args.in[9], args.in[10], args.in[11], args.in[12], args.in[13], args.in[14], args.in[15], WSs, W3);
        __syncthreads();
        LAS float* scr = (LAS float*)(lds + wave * 16384);
        constexpr int I_DD = 16 * 32, I_BIN = 16 * 96, I_KV = 16 * 64, I_W1 = 16 * 128, I_W2 = 64 * 32;
        constexpr int NITEMS = 3 * I_DD + I_BIN + I_DD + 2 * I_DD + 2 * I_KV + 2 * I_W1 + 2 * I_W2;
        for (int it = gw; it < NITEMS; it += NGW) {
            int r = it;
            if (transpose_job(r, args.in[7], D, D, norm_mix, WinT, 0, scr, lane)) continue;
            if (transpose_job(r, args.in[16], D, D, nullptr, WgluT, 0, scr, lane)) continue;
            if (transpose_job(r, args.in[17], D, D, nullptr, WoutT, 0, scr, lane)) continue;
            if (transpose_job(r, args.in[18], D, 3 * D, norm_mix + D, BinT, 1, scr, lane)) continue;
            if (transpose_job(r, args.in[20], D, D, nullptr, BoutT, 0, scr, lane)) continue;
            if (transpose_job(r, args.in[23], D, D, nullptr, WoT, 0, scr, lane)) continue;
            if (transpose_job(r, args.in[23] + (size_t)D * D, D, D, nullptr, WoT + (size_t)D * D, 0, scr, lane)) continue;
            if (transpose_job(r, args.in[22], D, 2 * D, norm_mem, WkvT, 0, scr, lane)) continue;
            if (transpose_job(r, args.in[22] + (size_t)D * 2 * D, D, 2 * D, norm_mem + D, WkvT + (size_t)2 * D * D, 0, scr, lane)) continue;
            if (transpose_job(r, args.in[24], D, FF, norm_ffn, W1T, 0, scr, lane)) continue;
            if (transpose_job(r, args.in[24] + (size_t)D * FF, D, FF, norm_ffn + D, W1T + (size_t)FF * D, 0, scr, lane)) continue;
            if (transpose_job(r, args.in[25], FF, D, nullptr, W2T, 0, scr, lane)) continue;
            transpose_job(r, args.in[25] + (size_t)FF * D, FF, D, nullptr, W2T + (size_t)D * FF, 0, scr, lane);
        }
        for (int rw = gw; rw < 2 * D; rw += NGW) { const float gsc = norm_xattn[rw] * 0.0625f; const f32x4* src = (const f32x4*)(args.in[21] + (size_t)rw * D) + lane; u32x2* dst = (u32x2*)(WqN + (size_t)rw * D) + lane;
#pragma unroll
            for (int j = 0; j < 4; ++j) { const f32x4 v = src[64 * j] * gsc; u32x2 o; o.x = cvt_pk_bf16(v[0], v[1]); o.y = cvt_pk_bf16(v[2], v[3]); dst[64 * j] = o; } }
        for (int t = gw; t < T; t += NGW) { const f32x4* src = (const f32x4*)(x + (size_t)t * D) + lane; u32x2* dst = (u32x2*)(Hb + (size_t)t * D) + lane; float s = 0.f;
#pragma unroll
            for (int j = 0; j < 4; ++j) { const f32x4 v = src[64 * j]; s += (v[0] * v[0] + v[1] * v[1]) + (v[2] * v[2] + v[3] * v[3]); u32x2 o; o.x = cvt_pk_bf16(v[0], v[1]); o.y = cvt_pk_bf16(v[2], v[3]); dst[64 * j] = o; }
            s = wave_sum(s); if (lane < 16) ssqp[(size_t)t * 16 + lane] = lane == 0 ? s : 0.f; }
        for (int t = gw; t < MEMT; t += NGW) { const f32x4* src = (const f32x4*)(mem + (size_t)t * D) + lane; u32x2* dst = (u32x2*)(memn + (size_t)t * D) + lane; f32x4 v[4]; float s = 0.f;
#pragma unroll
            for (int j = 0; j < 4; ++j) { v[j] = src[64 * j]; s += (v[j][0] * v[j][0] + v[j][1] * v[j][1]) + (v[j][2] * v[j][2] + v[j][3] * v[j][3]); }
            const float ri = __builtin_amdgcn_rsqf(wave_sum(s) * (1.0f / D) + EPS);
#pragma unroll
            for (int j = 0; j < 4; ++j) { u32x2 o; o.x = cvt_pk_bf16(v[j][0] * ri, v[j][1] * ri); o.y = cvt_pk_bf16(v[j][2] * ri, v[j][3] * ri); dst[64 * j] = o; } }
        SEAM(0);
    }
    if (IN(1)) {
        { pg8::Gemm g{Hb, WinT, D, 2048u, 32u, 128u, 2048u}; pg8::Order<pg8::MapG> S; S.init(T / 256, D / 256, G, bx, pg8::MapG{TS2K, TS2K, BIG, 0, BIG});
          pg8::EpiU E{UX, ssqp}; pg8::gemm_phase(lds, g, S, E); }
        { pg8::Gemm g{memn, WkvT, D, 2048u, 32u, 128u, 2048u}; pg8::Order<pg8::MapG> S; S.init(8, 8, G, bx, pg8::MapG{TS2K, TS2K, 4, 8, 4});
          pg8::EpiBf16Plain E{KV, 2 * D}; pg8::gemm_phase(lds, g, S, E); }
        SEAM(1);
    }
    if (IN(2)) {
        { pg8::Gemm g{UX, WSs, KS1, KS3 * 2u, 32u, 128u, KS1 * 2u}; pg8::Order<pg8::MapG> S; S.init(NG * NCH / 256, 1, G, bx, pg8::MapG{256L * KS3 * 2, 256L * KS1 * 2, 4, 1, BIG});
          pg8::EpiF32Plain E{Ssum, 256}; pg8::gemm_phase(lds, g, S, E); }
        struct MapWeff { __device__ __forceinline__ void map(int pm, int pn, pg8::Unit& u) const { u.pm = pm; u.pn = pn;
            u.aoff = ((long)(pm >> 2) * 256 * 2048 + (pm & 3) * 256) * 2; u.boff = ((long)(pm >> 4) * D * D + (long)pn * 256 * D + (pm & 3) * 256) * 2; } };
        { pg8::Gemm g{KV, WqN, 256, 4096u, 32u, 128u, 2048u}; pg8::Order<MapWeff> S; S.init(32, 4, G, bx, MapWeff{});
          pg8::EpiBf16Plain E{WeffT, D}; pg8::gemm_phase(lds, g, S, E); }
        struct MapVW { __device__ __forceinline__ void map(int pm, int pn, pg8::Unit& u) const { u.pm = pm; u.pn = pn;
            u.aoff = ((long)(pm >> 4) * D * D + (long)(pm & 3) * 256 * D + pn * 256) * 2; u.boff = ((long)(pm >> 2) * 256 * 2048 + 1024 + pn * 256) * 2; } };
        { pg8::Gemm g{WoT, KV, 256, 2048u, 32u, 128u, 4096u}; pg8::Order<MapVW> S; S.init(32, 4, G, bx, MapVW{});
          pg8::EpiBf16Plain E{VWT, D}; pg8::gemm_phase(lds, g, S, E); }
        SEAM(2);
    }
    if (IN(3)) {
        PHASE_IDS
        for (int it = vcu; it < NB * NG; it += G) {
            const int b = it & 3, g = it >> 2;
            if (wave < 2) {
                const int r = wave, p = lane; const int gi = (r * 64 + g) * 64 + p;
                const float lr = args.in[8][gi], li = args.in[9][gi], dt = expf(args.in[10][r * 64 + g]);
                const float mag = expf(32.0f * lr * dt), ang = 32.0f * li * dt; const float ax = mag * cosf(ang), ay = mag * sinf(ang);
                float X = 0.f, Y = 0.f;
                const size_t row0 = (size_t)g * NCH + (size_t)b * NCHB;
                for (int c0 = 0; c0 < NCHB; c0 += 8) {
                    float sx[8], sy[8];
#pragma unroll
                    for (int i = 0; i < 8; ++i) { const int c = r == 0 ? c0 + i : NCHB - 1 - (c0 + i); const float* sp = Ssum + (row0 + c) * 256 + r * 128 + p; sx[i] = sp[0]; sy[i] = sp[64]; }
#pragma unroll
                    for (int i = 0; i < 8; ++i) { const int c = r == 0 ? c0 + i : NCHB - 1 - (c0 + i); bf16_t* up = UX + (row0 + c) * KS3 + KS1 + r * 128 + p;
                        const unsigned w = cvt_pk_bf16(X, Y); up[0] = (bf16_t)(w & 0xffffu); up[64] = (bf16_t)(w >> 16);
                        const float nX = ax * X - ay * Y + sx[i], nY = ax * Y + ay * X + sy[i]; X = nX; Y = nY; }
                }
            }
        }
        SEAM(3);
    }
    if (IN(4)) {
        pg8::Gemm g{UX, W3, KS3, KS3 * 2u, 32u, 128u, KS3 * 2u}; pg8::Order<pg8::MapG> S; S.init(NG * NCH / 256, 2, G, bx, pg8::MapG{256L * KS3 * 2, 256L * KS3 * 2, 4, 2, BIG});
        pg8::EpiGelu E{Zgm}; pg8::gemm_phase(lds, g, S, E);
        SEAM(4);
    }
    if (IN(5)) {
        pg8::Gemm g{Zgm, WgluT, D, 32u, (unsigned)T * 32u, 4u * (unsigned)T * 32u, 2048u}; pg8::Order<pg8::MapG> S; S.init(T / 256, D / 256, G, bx, pg8::MapG{256L * 32, TS2K, BIG, 0, BIG});
        pg8::EpiGlu E{Zgm, Z2}; pg8::gemm_phase(lds, g, S, E);
        SEAM(5);
    }
    if (IN(6)) {
        pg8::Gemm g{Z2, WoutT, D, 2048u, 32u, 128u, 2048u}; pg8::Order<pg8::MapG> S; S.init(T / 256, D / 256, G, bx, pg8::MapG{TS2K, TS2K, BIG, 0, BIG});
        pg8::EpiRes E{x, H, Hb, ssqp}; pg8::gemm_phase(lds, g, S, E);
        SEAM(6);
    }
    for (int layer = 0; layer < 2; ++layer) {
        if (layer == 1) {
            if (IN(11)) {
                pg8::Gemm g{Hb, BinT, D, 2048u, 32u, 128u, 2048u}; pg8::Order<pg8::MapG> S; S.init(T / 256, 12, G, bx, pg8::MapG{TS2K, TS2K, BIG, 0, BIG});
                pg8::EpiBCV E{Zbv, Cg, ssqp}; pg8::gemm_phase(lds, g, S, E);
                SEAM(11);
            }
            if (IN(12)) {
                PHASE_IDS
                const float* cw = args.in[19];
                f32x4 w0[4], w1[4], w2[4];
#pragma unroll
                for (int j = 0; j < 4; ++j) { w0[j] = *(const f32x4*)(cw + 16 * lane + 4 * j); w1[j] = *(const f32x4*)(cw + D + 16 * lane + 4 * j); w2[j] = *(const f32x4*)(cw + 2 * D + 16 * lane + 4 * j); }
                for (int blk = gw; blk < T / 16; blk += NGW) {
                    const int t0 = blk * 16; f32x4 pv[4], cv[4], nv[4];
                    if ((t0 & (SEQ - 1)) == 0) {
#pragma unroll
                        for (int j = 0; j < 4; ++j) pv[j] = (f32x4){0.f, 0.f, 0.f, 0.f};
                    } else { const u32x4* zp = (const u32x4*)(Zbv + (size_t)(t0 - 1) * D + 16 * lane); pg8::unpack8(zp[0], pv[0], pv[1]); pg8::unpack8(zp[1], pv[2], pv[3]); }
                    { const u32x4* zp = (const u32x4*)(Zbv + (size_t)t0 * D + 16 * lane); pg8::unpack8(zp[0], cv[0], cv[1]); pg8::unpack8(zp[1], cv[2], cv[3]); }
                    for (int i = 0; i < 16; ++i) { const int t = t0 + i;
                        if ((t & (SEQ - 1)) == SEQ - 1) {
#pragma unroll
                            for (int j = 0; j < 4; ++j) nv[j] = (f32x4){0.f, 0.f, 0.f, 0.f};
                        } else { const u32x4* zp = (const u32x4*)(Zbv + (size_t)(t + 1) * D + 16 * lane); pg8::unpack8(zp[0], nv[0], nv[1]); pg8::unpack8(zp[1], nv[2], nv[3]); }
                        const u32x4* cp = (const u32x4*)(Cg + (size_t)t * D + 16 * lane); f32x4 gc[4]; pg8::unpack8(cp[0], gc[0], gc[1]); pg8::unpack8(cp[1], gc[2], gc[3]);
                        f32x4 o[4];
#pragma unroll
                        for (int j = 0; j < 4; ++j) { o[j] = gc[j] * (w0[j] * pv[j] + w1[j] * cv[j] + w2[j] * nv[j]); pv[j] = cv[j]; cv[j] = nv[j]; }
                        u32x4* op = (u32x4*)(Zc + (size_t)t * D + 16 * lane); op[0] = pg8::pack8(o[0], o[1]); op[1] = pg8::pack8(o[2], o[3]); }
                }
                SEAM(12);
            }
            if (IN(13)) {
                pg8::Gemm g{Zc, BoutT, D, 2048u, 32u, 128u, 2048u}; pg8::Order<pg8::MapG> S; S.init(T / 256, D / 256, G, bx, pg8::MapG{TS2K, TS2K, BIG, 0, BIG});
                pg8::EpiRes E{H, H, Hb, ssqp}; pg8::gemm_phase(lds, g, S, E);
                SEAM(13);
            }
        }
        const int pb = layer ? 14 : 7;
        if (IN(pb)) {
            pg8::Gemm g{Hb, WeffT + (size_t)layer * NB * D * D, D, 2048u, 32u, 128u, 2048u}; pg8::Order<pg8::MapG> S; S.init(T / 256, D / 256, G, bx, pg8::MapG{TS2K, TS2K, SEQ / 256, 4, BIG});
            pg8::EpiSoftmax E{Pm, ssqp, (LAS f32x2*)(lds + XCH_OFF)}; pg8::gemm_phase(lds, g, S, E);
            SEAM(pb);
        }
        if (IN(pb + 1)) {
            pg8::Gemm g{Pm, VWT + (size_t)layer * NB * D * D, D, 2048u, 32u, 128u, 2048u}; pg8::Order<pg8::MapG> S; S.init(T / 256, D / 256, G, bx, pg8::MapG{TS2K, TS2K, SEQ / 256, 4, BIG});
            pg8::EpiRes E{H, H, Hb, ssqp}; pg8::gemm_phase(lds, g, S, E);
            SEAM(pb + 1);
        }
        if (IN(pb + 2)) {
            pg8::Gemm g{Hb, W1T + (size_t)layer * FF * D, D, 2048u, 32u, 128u, 2048u}; pg8::Order<pg8::MapG> S; S.init(T / 256, FF / 256, G, bx, pg8::MapG{TS2K, TS2K, BIG, 0, BIG});
            pg8::EpiRelu2 E{Aff, ssqp}; pg8::gemm_phase(lds, g, S, E);
            SEAM(pb + 2);
        }
        if (IN(pb + 3)) {
            pg8::Gemm g{Aff, W2T + (size_t)layer * D * FF, FF, 8192u, 32u, 128u, 8192u}; pg8::Order<pg8::MapG> S; S.init(T / 256, D / 256, G, bx, pg8::MapG{256L * 8192, 256L * 8192, BIG, 0, BIG});
            pg8::EpiRes E{H, H, Hb, ssqp}; pg8::gemm_phase(lds, g, S, E);
            SEAM(pb + 3);
        }
    }
    if (IN(18)) {
        PHASE_IDS
        f32x4 gn[4];
#pragma unroll
        for (int j = 0; j < 4; ++j) gn[j] = ((const f32x4*)norm_final)[lane + 64 * j];
        for (int t = gw; t < T; t += NGW) { const float ri = pg8::row_rinv(ssqp, t); f32x4* hp = (f32x4*)(H + (size_t)t * D) + lane;
#pragma unroll
            for (int j = 0; j < 4; ++j) hp[64 * j] = hp[64 * j] * gn[j] * ri; }
    }
#undef IN
#undef SEAM
}

extern "C" void kernel_launch(void* const* d_in, const int* in_sizes, int n_in, void* d_out, int out_size, void* d_ws, size_t ws_size, hipStream_t stream) {
    static int grid = 0;
    if (grid == 0) {
        if (n_in != 26 || in_sizes[0] != T * D || out_size != T * D || ws_size < WS_END) {
            fprintf(stderr, "kernel_launch: built for 26 inputs, x/out of %d floats, >= %zu bytes of workspace; got n_in %d, in0 %d, out %d, ws %zu; nothing launched\n", T * D, (size_t)WS_END, n_in, n_in > 0 ? in_sizes[0] : -1, out_size, ws_size);
            grid = -1; return; }
        int dev = 0, cus = 0, per_cu = 0;
        if (hipGetDevice(&dev) != hipSuccess || hipDeviceGetAttribute(&cus, hipDeviceAttributeMultiprocessorCount, dev) != hipSuccess) { fprintf(stderr, "kernel_launch: device query failed\n"); grid = -1; return; }
        if (hipFuncSetAttribute((const void*)trunk_fwd, hipFuncAttributeMaxDynamicSharedMemorySize, LDS_BYTES) != hipSuccess) { fprintf(stderr, "kernel_launch: hipFuncSetAttribute failed\n"); grid = -1; return; }
        if (hipOccupancyMaxActiveBlocksPerMultiprocessor(&per_cu, (const void*)trunk_fwd, NWAVES * 64, LDS_BYTES) != hipSuccess || per_cu < 1)
            fprintf(stderr, "kernel_launch: note: occupancy query reports %d workgroups per CU\n", per_cu);
        (void)hipGetLastError();
        grid = cus;
    }
    if (grid < 0) return;
    if (hipMemsetAsync((char*)d_ws + WS_CTL, 0, CTL_ZERO_BYTES, stream) != hipSuccess) { fprintf(stderr, "kernel_launch: hipMemsetAsync failed\n"); return; }
    Args a{};
    for (int i = 0; i < 26; ++i) a.in[i] = (const float*)d_in[i];
    a.out = (float*)d_out; a.ws = (unsigned char*)d_ws;
#if MK_N_LAUNCHES == 1
    a.ph_lo = 0; a.ph_hi = N_PHASES; a.li = 0;
    void* kargs[] = {&a};
    hipError_t e = hipLaunchCooperativeKernel((const void*)trunk_fwd, dim3(grid), dim3(NWAVES * 64), kargs, LDS_BYTES, stream);
    if (e != hipSuccess) { fprintf(stderr, "kernel_launch: cooperative launch failed: %s (grid %d)\n", hipGetErrorString(e), grid); (void)hipGetLastError();
        hipLaunchKernelGGL(trunk_fwd, dim3(grid), dim3(NWAVES * 64), LDS_BYTES, stream, a); }
#else
    for (int ph = 0; ph < N_PHASES; ++ph) { a.ph_lo = ph; a.ph_hi = ph + 1; a.li = ph; hipLaunchKernelGGL(trunk_fwd, dim3(grid), dim3(NWAVES * 64), LDS_BYTES, stream, a); }
#endif
}
```

```cpp
#include <hip/hip_runtime.h>
#include <cstdio>
#include <cstdint>

#define LAS __attribute__((address_space(3)))
#define GAS __attribute__((address_space(1)))
typedef unsigned short bf16_t;
typedef short bf16x8 __attribute__((ext_vector_type(8)));
typedef float f32x4 __attribute__((ext_vector_type(4)));
typedef float f32x2 __attribute__((ext_vector_type(2)));
typedef unsigned u32x4 __attribute__((ext_vector_type(4)));
typedef unsigned u32x2 __attribute__((ext_vector_type(2)));

constexpr int T = 32768, D = 1024, FF = 4096, SEQ = 8192, NB = 4, MEMT = 1024, MEML = 256;
constexpr int NG = 64, CN = 32, NCH = T / CN, NCHB = SEQ / CN, KS1 = CN * 16, KS3 = CN * 16 + 256;
constexpr float EPS = 1e-6f;

namespace pg8 {
constexpr int BM = 256, BK = 64, HALF = 128, HTB = HALF * BK * 2, STAGE_BYTES = 8 * HTB, NXCD = 8, WGM = 8;
__host__ __device__ __forceinline__ int lds_byte(int r, int c) { const int st = (r >> 4) * 2 + (c >> 5), rr = r & 15, cc = c & 31, ob = rr * 64 + cc * 2; return st * 1024 + (ob ^ (((ob >> 9) & 1) << 5)); }
__host__ __device__ __forceinline__ void stage_rc(int b, int& R, int& C) { const int st = b / 1024, sb = b % 1024, swz = sb ^ (((sb >> 9) & 1) << 5); R = (st >> 1) * 16 + swz / 64; C = (st & 1) * 32 + (swz % 64) / 2; }
__host__ __device__ __forceinline__ int perm32(int rho) { const int n = rho >> 4, i = rho & 15; return 8 * (i >> 2) + 4 * n + (i & 3); }

struct Unit { int pm, pn; long aoff, boff; };
struct Gemm { const bf16_t* A; const bf16_t* Bt; int K; unsigned a_rs, a_c16, a_kstep, b_rs; };

template <class Map> struct Order {
    int nM, nN, nwg, G, c; Map mp;
    __device__ __forceinline__ void init(int nM_, int nN_, int G_, int c_, const Map& m) { nM = nM_; nN = nN_; nwg = nM * nN; G = G_; c = c_; mp = m; }
    __device__ __forceinline__ bool next(int i, Unit& u) const {
        const long L = (long)i * G + c; if (L >= nwg) return false;
        int wgid = (int)L; { const int q = nwg / NXCD, r = nwg % NXCD, xcd = wgid % NXCD, off = wgid / NXCD; wgid = (xcd < r ? xcd * (q + 1) : r * (q + 1) + (xcd - r) * q) + off; }
        const int nig = WGM * nN, gid = wgid / nig, fm = gid * WGM, gsz = (nM - fm) < WGM ? (nM - fm) : WGM;
        const int pm = fm + ((wgid % nig) % gsz), pn = (wgid % nig) / gsz;
        mp.map(pm, pn, u); return true;
    }
};
struct MapG { long a_t, b_t; int grp_m, nNb, a_mod;
    __device__ __forceinline__ void map(int pm, int pn, Unit& u) const { u.pm = pm; u.pn = pn; u.aoff = (long)(pm % a_mod) * a_t; u.boff = (long)((pm / grp_m) * nNb + pn) * b_t; } };

__device__ __forceinline__ unsigned cvt_pk_bf16(float lo, float hi) { unsigned r; asm volatile("v_cvt_pk_bf16_f32 %0, %1, %2" : "=v"(r) : "v"(lo), "v"(hi)); return r; }
__device__ __forceinline__ u32x4 pack8(const f32x4 a, const f32x4 b) { u32x4 w; w.x = cvt_pk_bf16(a[0], a[1]); w.y = cvt_pk_bf16(a[2], a[3]); w.z = cvt_pk_bf16(b[0], b[1]); w.w = cvt_pk_bf16(b[2], b[3]); return w; }
__device__ __forceinline__ void unpack8(const u32x4 w, f32x4& a, f32x4& b) {
    a[0] = __uint_as_float(w.x << 16); a[1] = __uint_as_float(w.x & 0xffff0000u); a[2] = __uint_as_float(w.y << 16); a[3] = __uint_as_float(w.y & 0xffff0000u);
    b[0] = __uint_as_float(w.z << 16); b[1] = __uint_as_float(w.z & 0xffff0000u); b[2] = __uint_as_float(w.w << 16); b[3] = __uint_as_float(w.w & 0xffff0000u); }
__device__ __forceinline__ float row_rinv(const float* ssqp, int row) {
    const f32x4* p = (const f32x4*)(ssqp + (size_t)row * 16); const f32x4 a = p[0], b = p[1], c = p[2], d = p[3];
    const f32x4 s = (a + b) + (c + d); return __builtin_amdgcn_rsqf(((s[0] + s[1]) + (s[2] + s[3])) * (1.0f / 1024.0f) + EPS); }

#define EPI_ROWS_BEGIN _Pragma("unroll") for (int ai = 0; ai < 2; ++ai) _Pragma("unroll") for (int m = 0; m < 4; ++m) { const int rt = ai * 128 + wr * 64 + m * 16 + fr; const int row = u.pm * 256 + rt; (void)row;
#define EPI_ROWS_END }
#define EPI_COLS_BEGIN _Pragma("unroll") for (int bj = 0; bj < 2; ++bj) { const int ct = bj * 128 + wc * 32 + 8 * fq; (void)ct;
#define EPI_COLS_END }

struct EpiBf16Plain {
    bf16_t* O; int ldc;
    __device__ __forceinline__ void operator()(f32x4 (&acc)[2][2][4][2], const Unit& u, int wr, int wc, int fr, int fq) const {
        EPI_ROWS_BEGIN bf16_t* rowp = O + (size_t)row * ldc + u.pn * 256;
        EPI_COLS_BEGIN *(u32x4*)(rowp + ct) = pack8(acc[ai][bj][m][0], acc[ai][bj][m][1]); EPI_COLS_END
        EPI_ROWS_END }
};
struct EpiF32Plain {
    float* O; int ldc;
    __device__ __forceinline__ void operator()(f32x4 (&acc)[2][2][4][2], const Unit& u, int wr, int wc, int fr, int fq) const {
        EPI_ROWS_BEGIN float* rowp = O + (size_t)row * ldc + u.pn * 256;
        EPI_COLS_BEGIN *(f32x4*)(rowp + ct) = acc[ai][bj][m][0]; *(f32x4*)(rowp + ct + 4) = acc[ai][bj][m][1]; EPI_COLS_END
        EPI_ROWS_END }
};
struct EpiU {
    bf16_t* UX; const float* ssqp;
    __device__ __forceinline__ void operator()(f32x4 (&acc)[2][2][4][2], const Unit& u, int wr, int wc, int fr, int fq) const {
        EPI_ROWS_BEGIN const float ri = row_rinv(ssqp, row); const int ch = row >> 5, tau = row & 31;
        EPI_COLS_BEGIN const int col = u.pn * 256 + ct, g = col >> 4, h0 = col & 15;
            *(u32x4*)(UX + ((size_t)g * NCH + ch) * KS3 + tau * 16 + h0) = pack8(acc[ai][bj][m][0] * ri, acc[ai][bj][m][1] * ri); EPI_COLS_END
        EPI_ROWS_END }
};
__device__ __forceinline__ float gelu_tanh(float x) {
    const float t = x * (0.7978845608f + 0.0356774081f * x * x);
    return x * __builtin_amdgcn_rcpf(1.0f + __builtin_amdgcn_exp2f(-2.8853900818f * t)); }
__device__ __forceinline__ float sigmoidf_(float x) { return __builtin_amdgcn_rcpf(1.0f + __builtin_amdgcn_exp2f(-1.4426950409f * x)); }
struct EpiGelu {
    bf16_t* O;
    __device__ __forceinline__ void operator()(f32x4 (&acc)[2][2][4][2], const Unit& u, int wr, int wc, int fr, int fq) const {
        EPI_ROWS_BEGIN bf16_t* rowp = O + (size_t)row * 512 + u.pn * 256;
        EPI_COLS_BEGIN f32x4 a = acc[ai][bj][m][0], b = acc[ai][bj][m][1];
#pragma unroll
            for (int e = 0; e < 4; ++e) { a[e] = gelu_tanh(a[e]); b[e] = gelu_tanh(b[e]); }
            *(u32x4*)(rowp + ct) = pack8(a, b); EPI_COLS_END
        EPI_ROWS_END }
};
struct EpiGlu {
    const bf16_t* Zgm; bf16_t* Z2;
    __device__ __forceinline__ void operator()(f32x4 (&acc)[2][2][4][2], const Unit& u, int wr, int wc, int fr, int fq) const {
        EPI_ROWS_BEGIN
        EPI_COLS_BEGIN const int col = u.pn * 256 + ct; const u32x4 zw = *(const u32x4*)(Zgm + ((size_t)(col >> 4) * T + row) * 16 + (col & 15));
            f32x4 za, zb; unpack8(zw, za, zb); f32x4 a = acc[ai][bj][m][0], b = acc[ai][bj][m][1];
#pragma unroll
            for (int e = 0; e < 4; ++e) { a[e] = za[e] * sigmoidf_(a[e]); b[e] = zb[e] * sigmoidf_(b[e]); }
            *(u32x4*)(Z2 + (size_t)row * D + col) = pack8(a, b); EPI_COLS_END
        EPI_ROWS_END }
};
struct EpiRes {
    const float* base; float* out; bf16_t* Hb; float* ssqp;
    __device__ __forceinline__ void operator()(f32x4 (&acc)[2][2][4][2], const Unit& u, int wr, int wc, int fr, int fq) const {
        EPI_ROWS_BEGIN float ss = 0.f;
        EPI_COLS_BEGIN const size_t off = (size_t)row * D + u.pn * 256 + ct;
            const f32x4 a = *(const f32x4*)(base + off) + acc[ai][bj][m][0], b = *(const f32x4*)(base + off + 4) + acc[ai][bj][m][1];
            *(f32x4*)(out + off) = a; *(f32x4*)(out + off + 4) = b; *(u32x4*)(Hb + off) = pack8(a, b);
            ss += (a[0] * a[0] + a[1] * a[1]) + (a[2] * a[2] + a[3] * a[3]) + (b[0] * b[0] + b[1] * b[1]) + (b[2] * b[2] + b[3] * b[3]); EPI_COLS_END
            ss += __shfl_xor(ss, 16); ss += __shfl_xor(ss, 32);
            if (fq == 0) ssqp[(size_t)row * 16 + u.pn * 4 + wc] = ss;
            if (m & 1) asm volatile("" ::: "memory");
        EPI_ROWS_END }
};
struct EpiRelu2 {
    bf16_t* O; const float* ssqp;
    __device__ __forceinline__ void operator()(f32x4 (&acc)[2][2][4][2], const Unit& u, int wr, int wc, int fr, int fq) const {
        EPI_ROWS_BEGIN const float ri = row_rinv(ssqp, row); bf16_t* rowp = O + (size_t)row * FF + u.pn * 256;
        EPI_COLS_BEGIN f32x4 a = acc[ai][bj][m][0] * ri, b = acc[ai][bj][m][1] * ri;
#pragma unroll
            for (int e = 0; e < 4; ++e) { a[e] = fmaxf(a[e], 0.f); a[e] *= a[e]; b[e] = fmaxf(b[e], 0.f); b[e] *= b[e]; }
            *(u32x4*)(rowp + ct) = pack8(a, b); EPI_COLS_END
        EPI_ROWS_END }
};
struct EpiBCV {
    bf16_t* Zbv; bf16_t* Cg; const float* ssqp;
    __device__ __forceinline__ void operator()(f32x4 (&acc)[2][2][4][2], const Unit& u, int wr, int wc, int fr, int fq) const {
        if (u.pn < 8) {
            EPI_ROWS_BEGIN const float ri = row_rinv(ssqp, row), r2 = ri * ri;
                *(u32x4*)(Zbv + (size_t)row * D + u.pn * 128 + wc * 32 + 8 * fq) = pack8(acc[ai][0][m][0] * acc[ai][1][m][0] * r2, acc[ai][0][m][1] * acc[ai][1][m][1] * r2);
            EPI_ROWS_END
        } else {
            EPI_ROWS_BEGIN const float ri = row_rinv(ssqp, row); bf16_t* rowp = Cg + (size_t)row * D + (u.pn - 8) * 256;
            EPI_COLS_BEGIN *(u32x4*)(rowp + ct) = pack8(acc[ai][bj][m][0] * ri, acc[ai][bj][m][1] * ri); EPI_COLS_END
            EPI_ROWS_END
        }
    }
};
struct EpiSoftmax {
    bf16_t* P; const float* ssqp; LAS f32x2* xch;
    __device__ __forceinline__ void operator()(f32x4 (&acc)[2][2][4][2], const Unit& u, int wr, int wc, int fr, int fq) const {
        float mw[2][4];
        EPI_ROWS_BEGIN const float ri = row_rinv(ssqp, row) * 1.4426950409f; float mx = -3.0e38f;
        EPI_COLS_BEGIN
#pragma unroll
            for (int n = 0; n < 2; ++n) { acc[ai][bj][m][n] = acc[ai][bj][m][n] * ri; const f32x4 v = acc[ai][bj][m][n]; mx = fmaxf(mx, fmaxf(fmaxf(v[0], v[1]), fmaxf(v[2], v[3]))); } EPI_COLS_END
            mx = fmaxf(mx, __shfl_xor(mx, 16)); mx = fmaxf(mx, __shfl_xor(mx, 32)); float sm = 0.f;
        EPI_COLS_BEGIN
#pragma unroll
            for (int n = 0; n < 2; ++n) { f32x4 v = acc[ai][bj][m][n];
#pragma unroll
                for (int e = 0; e < 4; ++e) { v[e] = __builtin_amdgcn_exp2f(v[e] - mx); sm += v[e]; } acc[ai][bj][m][n] = v; } EPI_COLS_END
            sm += __shfl_xor(sm, 16); sm += __shfl_xor(sm, 32); mw[ai][m] = mx;
            if (fq == 0) xch[rt * 4 + wc] = (f32x2){mx, sm};
        EPI_ROWS_END
        asm volatile("s_waitcnt lgkmcnt(0)" ::: "memory"); __builtin_amdgcn_s_barrier(); asm volatile("" ::: "memory");
        EPI_ROWS_BEGIN const f32x2 p0 = xch[rt * 4 + 0], p1 = xch[rt * 4 + 1], p2 = xch[rt * 4 + 2], p3 = xch[rt * 4 + 3];
            const float M = fmaxf(fmaxf(p0.x, p1.x), fmaxf(p2.x, p3.x));
            const float Ls = (p0.y * __builtin_amdgcn_exp2f(p0.x - M) + p1.y * __builtin_amdgcn_exp2f(p1.x - M)) + (p2.y * __builtin_amdgcn_exp2f(p2.x - M) + p3.y * __builtin_amdgcn_exp2f(p3.x - M));
            const float f = __builtin_amdgcn_exp2f(mw[ai][m] - M) * __builtin_amdgcn_rcpf(Ls); bf16_t* rowp = P + (size_t)row * D + u.pn * 256;
        EPI_COLS_BEGIN *(u32x4*)(rowp + ct) = pack8(acc[ai][bj][m][0] * f, acc[ai][bj][m][1] * f); EPI_COLS_END
        EPI_ROWS_END
        asm volatile("s_waitcnt lgkmcnt(0)" ::: "memory"); __builtin_amdgcn_s_barrier(); asm volatile("" ::: "memory");
    }
};

template <class Epi, class Sched>
__device__ __forceinline__ void gemm_phase(LAS unsigned char* lds, const Gemm g, const Sched& S, const Epi& E) {
    int tid = threadIdx.x; asm volatile("" : "+v"(tid));
    const int wid = __builtin_amdgcn_readfirstlane(tid >> 6), lane = tid & 63, wr = wid >> 2, wc = wid & 3, fr = lane & 15, fq = lane >> 4;
    const int nt = g.K / BK;
    unsigned voffA[2], voffB[2];
#pragma unroll
    for (int i = 0; i < 2; ++i) { int R, C; stage_rc(tid * 16 + i * 8192, R, C); const int Rb = (R & ~31) + perm32(R & 31);
        voffA[i] = (unsigned)R * g.a_rs + (unsigned)(C >> 4) * g.a_c16 + (unsigned)(C & 15) * 2u; voffB[i] = (unsigned)Rb * g.b_rs + (unsigned)C * 2u; }
    const size_t kstepA = (size_t)g.a_kstep, kstepB = (size_t)(BK * 2);
    const size_t hstepA = (size_t)HALF * g.a_rs, hstepB = (size_t)HALF * g.b_rs;
    const unsigned ldsw = (unsigned)wid * 1024u;
    const int aoff = lds_byte(wr * 64 + fr, fq * 8), boff = lds_byte(wc * 32 + fr, fq * 8);
#define PG8_SA(b, h) (((b) * 2 + (h)) * HTB)
#define PG8_SB(b, h) ((4 + (b) * 2 + (h)) * HTB)
#define PG8_STAGE(bufoff, gbase, voff) do { _Pragma("unroll") for (int _i = 0; _i < 2; ++_i) \
        __builtin_amdgcn_global_load_lds((const unsigned*)((const char*)(gbase) + (voff)[_i]), (LAS unsigned*)(lds + (bufoff) + ldsw + _i * 8192), 16, 0, 0); } while (0)
#define PG8_LDA(dst, b, h) do { _Pragma("unroll") for (int m = 0; m < 4; ++m) _Pragma("unroll") for (int k = 0; k < 2; ++k) dst[m][k] = *(const LAS bf16x8*)(lds + PG8_SA(b, h) + aoff + m * 2048 + k * 1024); } while (0)
#define PG8_LDB(dst, b, h) do { _Pragma("unroll") for (int n = 0; n < 2; ++n) _Pragma("unroll") for (int k = 0; k < 2; ++k) dst[n][k] = *(const LAS bf16x8*)(lds + PG8_SB(b, h) + boff + n * 2048 + k * 1024); } while (0)
#define PG8_MMA(ai, bj, At, Bt) do { __builtin_amdgcn_s_setprio(1); _Pragma("unroll") for (int m = 0; m < 4; ++m) _Pragma("unroll") for (int n = 0; n < 2; ++n) _Pragma("unroll") for (int k = 0; k < 2; ++k) \
        acc[ai][bj][m][n] = __builtin_amdgcn_mfma_f32_16x16x32_bf16(Bt[n][k], At[m][k], acc[ai][bj][m][n], 0, 0, 0); __builtin_amdgcn_s_setprio(0); } while (0)
#define PG8_WAIT_V(n) asm volatile("s_waitcnt vmcnt(" #n ")" ::: "memory")
#define PG8_WAIT_L(n) asm volatile("s_waitcnt lgkmcnt(" #n ")" ::: "memory")
#define PG8_BAR __builtin_amdgcn_s_barrier()
#define PG8_SCHED __builtin_amdgcn_sched_barrier(0)
    Unit cur, nxt; int ui = 0;
    if (!S.next(0, cur)) return;
    f32x4 acc[2][2][4][2];
#pragma unroll
    for (int a = 0; a < 2; ++a)
#pragma unroll
        for (int b = 0; b < 2; ++b)
#pragma unroll
            for (int m = 0; m < 4; ++m)
#pragma unroll
                for (int n = 0; n < 2; ++n) acc[a][b][m][n] = (f32x4){0.f, 0.f, 0.f, 0.f};
    bf16x8 At[4][2], B0[2][2], B1[2][2];
    const char* cA = (const char*)g.A + cur.aoff; const char* cB = (const char*)g.Bt + cur.boff;
    PG8_STAGE(PG8_SB(0, 0), cB, voffB); PG8_STAGE(PG8_SB(0, 1), cB + hstepB, voffB); PG8_STAGE(PG8_SA(0, 0), cA, voffA); PG8_STAGE(PG8_SA(0, 1), cA + hstepA, voffA);
    if (wr == 1) PG8_BAR;
    PG8_WAIT_V(2); PG8_BAR;
    PG8_STAGE(PG8_SB(1, 0), cB + kstepB, voffB); PG8_STAGE(PG8_SA(1, 0), cA + kstepA, voffA); PG8_STAGE(PG8_SB(1, 1), cB + hstepB + kstepB, voffB);
    PG8_WAIT_V(6); PG8_BAR;
#pragma nounroll
    for (;;) {
        const bool has_next = S.next(ui + 1, nxt);
        const char* nA = has_next ? (const char*)g.A + nxt.aoff : cA; const char* nB = has_next ? (const char*)g.Bt + nxt.boff : cB;
#pragma nounroll
        for (int t = 0; t < nt; t += 2) {
            const bool last = (t == nt - 2);
            const char* a1 = cA + (size_t)(t + 1) * kstepA;
            const char* a2 = last ? nA : cA + (size_t)(t + 2) * kstepA; const char* b2 = last ? nB : cB + (size_t)(t + 2) * kstepB;
            const char* a3 = a2 + kstepA; const char* b3 = b2 + kstepB;
            PG8_LDB(B0, 0, 0); PG8_LDB(B1, 0, 1); PG8_SCHED; PG8_LDA(At, 0, 0); PG8_STAGE(PG8_SA(1, 1), a1 + hstepA, voffA);
            PG8_WAIT_V(8); PG8_WAIT_L(0); PG8_BAR; PG8_MMA(0, 0, At, B0); PG8_MMA(0, 1, At, B1); PG8_BAR; PG8_SCHED;
            PG8_LDA(At, 0, 1); PG8_STAGE(PG8_SB(0, 0), b2, voffB); PG8_STAGE(PG8_SB(0, 1), b2 + hstepB, voffB); PG8_STAGE(PG8_SA(0, 0), a2, voffA);
            PG8_WAIT_V(8); PG8_WAIT_L(0); PG8_BAR; PG8_MMA(1, 0, At, B0); PG8_MMA(1, 1, At, B1); PG8_BAR; PG8_SCHED;
            PG8_LDB(B0, 1, 0); PG8_LDB(B1, 1, 1); PG8_SCHED; PG8_LDA(At, 1, 0); PG8_STAGE(PG8_SA(0, 1), a2 + hstepA, voffA);
            PG8_WAIT_V(8); PG8_WAIT_L(0); PG8_BAR; PG8_MMA(0, 0, At, B0); PG8_MMA(0, 1, At, B1); PG8_BAR; PG8_SCHED;
            PG8_LDA(At, 1, 1); PG8_STAGE(PG8_SB(1, 0), b3, voffB); PG8_STAGE(PG8_SB(1, 1), b3 + hstepB, voffB); PG8_STAGE(PG8_SA(1, 0), a3, voffA);
            PG8_WAIT_V(8); PG8_WAIT_L(0); PG8_BAR; PG8_MMA(1, 0, At, B0); PG8_MMA(1, 1, At, B1); PG8_BAR; PG8_SCHED;
        }
        if (wr == 0) PG8_BAR;
        E(acc, cur, wr, wc, fr, fq);
        if (!has_next) break;
#pragma unroll
        for (int a = 0; a < 2; ++a)
#pragma unroll
            for (int b = 0; b < 2; ++b)
#pragma unroll
                for (int m = 0; m < 4; ++m)
#pragma unroll
                    for (int n = 0; n < 2; ++n) acc[a][b][m][n] = (f32x4){0.f, 0.f, 0.f, 0.f};
        cur = nxt; cA = nA; cB = nB; ++ui;
        if (wr == 1) PG8_BAR;
    }
    PG8_WAIT_V(0);
    PG8_BAR;
#undef PG8_SA
#undef PG8_SB
#undef PG8_STAGE
#undef PG8_LDA
#undef PG8_LDB
#undef PG8_MMA
#undef PG8_WAIT_V
#undef PG8_WAIT_L
#undef PG8_BAR
#undef PG8_SCHED
}
}

constexpr size_t MiB = 1u << 20;
constexpr size_t WS_CTL = 0, CTL_ZERO_BYTES = 64 * 1024;
constexpr size_t WS_WINT = 1 * MiB, WS_WGLUT = 3 * MiB, WS_WOUTT = 5 * MiB, WS_BINT = 7 * MiB, WS_BOUTT = 13 * MiB, WS_WQN = 15 * MiB, WS_WOT = 19 * MiB,
                 WS_WKVT = 23 * MiB, WS_W1T = 31 * MiB, WS_W2T = 47 * MiB;
constexpr size_t WS_MEMN = 63 * MiB, WS_KV = 65 * MiB, WS_WEFFT = 73 * MiB, WS_VWT = 89 * MiB, WS_HB = 105 * MiB, WS_SSQP = 169 * MiB;
constexpr size_t WS_WS = 171 * MiB, WS_W3 = 187 * MiB, WS_UX = 235 * MiB, WS_S = 331 * MiB, WS_ZGM = 395 * MiB;
constexpr size_t WS_Z2 = 235 * MiB, WS_P = 171 * MiB, WS_AFF = 235 * MiB, WS_ZBV = 235 * MiB, WS_CG = 299 * MiB, WS_ZC = 363 * MiB, WS_END = 491 * MiB;
constexpr int CW_BAR = 4096;
constexpr int RING_BYTES = 131072, XCH_OFF = RING_BYTES, MISC_OFF = RING_BYTES + 8192 + 1024, LDS_BYTES = 147456;
constexpr int NWAVES = 8;

#define RLX_AGENT __ATOMIC_RELAXED, __HIP_MEMORY_SCOPE_AGENT
#define LDS_WAIT() asm volatile("s_waitcnt lgkmcnt(0)" ::: "memory")
#define VM_WAIT() asm volatile("s_waitcnt vmcnt(0)" ::: "memory")

#define XB_TMO      128
#define XB_XCNT(j)  (256  + 64 * (j))
#define XB_XSUB(j)  (1280 + 64 * (j))
#define XB_XGEN(j)  (2304 + 64 * (j))
#define XB_TOP      3328
#define XB_TOPGEN   3392
#define XCD_BAR_WORDS 3456
#define XB_SPIN_CAP (1u << 20)
__device__ __forceinline__ unsigned xb_ld(unsigned* p)              { return __hip_atomic_load(p, __ATOMIC_RELAXED, __HIP_MEMORY_SCOPE_AGENT); }
__device__ __forceinline__ unsigned xb_add(unsigned* p, unsigned v) { return __hip_atomic_fetch_add(p, v, __ATOMIC_RELAXED, __HIP_MEMORY_SCOPE_AGENT); }
__device__ __forceinline__ unsigned xb_xcc_id() { return (unsigned)__builtin_amdgcn_s_getreg((3 << 11) | 20) & 0xFu; }
#define XB_SPIN(cond, bar) do { unsigned _sp = 0; while (cond) { __builtin_amdgcn_s_sleep(1); \
    if ((++_sp & 255u) == 0u) { if (xb_ld(&(bar)[XB_TMO])) break; if (_sp > XB_SPIN_CAP) { atomicAdd(&(bar)[XB_TMO], 1u); break; } } } } while (0)
struct XcdBarrier { unsigned* bar; unsigned x; volatile LAS unsigned* st; };
__device__ __forceinline__ XcdBarrier xcd_barrier_post(unsigned* bar, volatile LAS unsigned* st) {
    XcdBarrier b; b.bar = bar; b.x = xb_xcc_id(); b.st = st;
    if (threadIdx.x == 0) (void)xb_add(&bar[XB_XCNT(b.x)], 1u);
    return b;
}
__device__ __forceinline__ void xcd_barrier_complete(unsigned* bar, unsigned x, unsigned& nloc, unsigned& nx) {
    const unsigned G = gridDim.x * gridDim.y * gridDim.z;
    unsigned sum, cnt, mine, sp = 0u;
    for (;;) {
        sum = 0u; cnt = 0u; mine = 0u;
#pragma unroll
        for (unsigned j = 0; j < 16; ++j) { const unsigned c = xb_ld(&bar[XB_XCNT(j)]); sum += c; cnt += (c > 0u) ? 1u : 0u; mine = (j == x) ? c : mine; }
        if (sum == G) break;
        __builtin_amdgcn_s_sleep(1);
        if ((++sp & 255u) == 0u) { if (xb_ld(&bar[XB_TMO])) break; if (sp > XB_SPIN_CAP) { atomicAdd(&bar[XB_TMO], 1u); break; } }
    }
    nloc = mine > 0u ? mine : 1u; nx = cnt > 0u ? cnt : 1u;
}
__device__ __forceinline__ void xcd_barrier(const XcdBarrier& b) {
    asm volatile("s_waitcnt vmcnt(0)" ::: "memory");
    __syncthreads();
    if (threadIdx.x == 0) {
        unsigned* bar = b.bar;
        __builtin_amdgcn_s_waitcnt(0);
        unsigned nloc = b.st[0], nx = b.st[1];
        if (nloc == 0u) { xcd_barrier_complete(bar, b.x, nloc, nx); b.st[0] = nloc; b.st[1] = nx; }
        const unsigned old = xb_add(&bar[XB_XSUB(b.x)], 1u);
        const unsigned gen = old / nloc;
        if (old + 1u == (gen + 1u) * nloc) {
            __builtin_amdgcn_fence(__ATOMIC_RELEASE, "agent");
            asm volatile("s_waitcnt vmcnt(0)" ::: "memory");
            const unsigned og = xb_add(&bar[XB_TOP], 1u);
            const unsigned tg = og / nx;
            if (og + 1u == (tg + 1u) * nx) xb_add(&bar[XB_TOPGEN], 1u);
            else XB_SPIN(xb_ld(&bar[XB_TOPGEN]) == tg, bar);
            __builtin_amdgcn_fence(__ATOMIC_ACQUIRE, "agent");
            xb_add(&bar[XB_XGEN(b.x)], 1u);
            asm volatile("s_waitcnt vmcnt(0)" ::: "memory");
        } else {
            XB_SPIN(xb_ld(&bar[XB_XGEN(b.x)]) == gen, bar);
            __builtin_amdgcn_fence(__ATOMIC_ACQUIRE, "agent");
            asm volatile("s_waitcnt vmcnt(0)" ::: "memory");
        }
    }
    __syncthreads();
}

__device__ __forceinline__ float wave_sum(float v) {
#pragma unroll
    for (int o = 1; o < 64; o <<= 1) v += __shfl_xor(v, o);
    return v;
}
using pg8::cvt_pk_bf16;
__device__ __forceinline__ void transpose_item(const float* W, int ldw, int k0, int n0, const float* gain, bf16_t* WT, int K, int drow0, LAS float* scr, int lane) {
#pragma unroll 8
    for (int i = 0; i < 32; ++i) { const int kk = 2 * i + (lane >> 5); float v = W[(size_t)(k0 + kk) * ldw + n0 + (lane & 31)]; if (gain) v *= gain[k0 + kk]; scr[kk * 33 + (lane & 31)] = v; }
    LDS_WAIT(); asm volatile("" ::: "memory");
    const int c = lane & 7;
#pragma unroll
    for (int j = 0; j < 4; ++j) { const int n = (lane >> 3) + 8 * j; const LAS float* s = scr + (8 * c) * 33 + n;
        u32x4 o; o.x = cvt_pk_bf16(s[0 * 33], s[1 * 33]); o.y = cvt_pk_bf16(s[2 * 33], s[3 * 33]); o.z = cvt_pk_bf16(s[4 * 33], s[5 * 33]); o.w = cvt_pk_bf16(s[6 * 33], s[7 * 33]);
        *(u32x4*)(WT + (size_t)(drow0 + n) * K + k0 + 8 * c) = o; }
    LDS_WAIT(); asm volatile("" ::: "memory");
}
__device__ __forceinline__ bool transpose_job(int& r, const float* W, int K, int N, const float* gain, bf16_t* WT, int kind, LAS float* scr, int lane) {
    const int nblk = N / 32, items = (K / 64) * nblk;
    if (r >= items) { r -= items; return false; }
    const int kb = r / nblk, nb = r % nblk, n0 = nb * 32; int drow0 = n0;
    if (kind == 1) { if (n0 < 1024) drow0 = 256 * (n0 >> 7) + (n0 & 127); else if (n0 < 2048) drow0 = 2048 + (n0 - 1024); else drow0 = 256 * ((n0 - 2048) >> 7) + 128 + ((n0 - 2048) & 127); }
    transpose_item(W, N, kb * 64, n0, gain, WT, K, drow0, scr, lane); return true;
}

typedef f32x2 cf;
__device__ __forceinline__ cf mkcf(float a, float b) { cf r; r.x = a; r.y = b; return r; }
__device__ __forceinline__ cf cmul(cf a, cf b) { return mkcf(a.x * b.x - a.y * b.y, a.x * b.y + a.y * b.x); }

__device__ __forceinline__ void ssm_tables(LAS unsigned char* lds, int g, int q, const float* lre, const float* lim, const float* logdt, const float* bre, const float* bim,
                                           const float* cre, const float* cim, const float* dd, bf16_t* WS, bf16_t* W3) {
    LAS cf* apow = (LAS cf*)lds; LAS cf* Bb = apow + 2 * 33 * 64; LAS cf* Cc = Bb + 2 * 64 * 16; LAS float* Kt = (LAS float*)(Cc + 2 * 16 * 64);
    const int tid = threadIdx.x;
    if (tid < 128) {
        const int r = tid >> 6, p = tid & 63; const int gi = (r * 64 + g) * 64 + p;
        const float lr = lre[gi], li = lim[gi], dt = expf(logdt[r * 64 + g]); const float x = lr * dt, y = li * dt;
        for (int k = 0; k <= 32; ++k) { const float mag = expf((float)k * x), ang = (float)k * y; apow[(r * 33 + k) * 64 + p] = mkcf(mag * cosf(ang), mag * sinf(ang)); }
        const float sh = sinf(0.5f * y); const cf am1 = mkcf(expm1f(x) * cosf(y) - 2.0f * sh * sh, expf(x) * sinf(y));
        const float den = 1.0f / (lr * lr + li * li); const cf coef = mkcf((am1.x * lr + am1.y * li) * den, (am1.y * lr - am1.x * li) * den);
        for (int h = 0; h < 16; ++h) { const cf b = mkcf(bre[(size_t)gi * 16 + h], bim[(size_t)gi * 16 + h]); Bb[(r * 64 + p) * 16 + h] = cmul(coef, b); }
    }
    for (int j = 0; j < 4; ++j) { const int idx = tid + 512 * j, r = idx >> 10, h = (idx >> 6) & 15, p = idx & 63; const size_t gi = ((size_t)(r * 64 + g) * 16 + h) * 64 + p; Cc[idx] = mkcf(cre[gi], cim[gi]); }
    __syncthreads();
    {
        const int r = tid >> 8, h = (tid >> 4) & 15, hp = tid & 15; float acc[32];
#pragma unroll
        for (int k = 0; k < 32; ++k) acc[k] = 0.f;
        for (int p = 0; p < 64; ++p) { const cf cb = cmul(Cc[(r * 16 + h) * 64 + p], Bb[(r * 64 + p) * 16 + hp]);
#pragma unroll
            for (int k = 0; k < 32; ++k) { const cf ap = apow[(r * 33 + k) * 64 + p]; acc[k] += cb.x * ap.x - cb.y * ap.y; } }
#pragma unroll
        for (int k = 0; k < 32; ++k) Kt[(r * 32 + k) * 256 + h * 16 + hp] = acc[k];
    }
    __syncthreads();
    {
        const int r = q >> 1, im = q & 1;
        for (int j = 0; j < 8; ++j) { const int idx = tid + 512 * j, p = idx >> 6, kc = idx & 63, s = kc >> 1, h0 = (kc & 1) * 8, e = r == 0 ? 31 - s : s;
            const cf ap = apow[(r * 33 + e) * 64 + p]; float v[8];
#pragma unroll
            for (int i = 0; i < 8; ++i) { const cf z = cmul(ap, Bb[(r * 64 + p) * 16 + h0 + i]); v[i] = im ? z.y : z.x; }
            u32x4 o; o.x = cvt_pk_bf16(v[0], v[1]); o.y = cvt_pk_bf16(v[2], v[3]); o.z = cvt_pk_bf16(v[4], v[5]); o.w = cvt_pk_bf16(v[6], v[7]);
            *(u32x4*)(WS + ((size_t)(g * 256 + 64 * q + p) * KS1 + kc * 8)) = o; }
    }
    {
        for (int j = 0; j < 24; ++j) { const int idx = tid + 512 * j, lrow = idx / 96, kc = idx % 96, n = 128 * q + lrow, tau = n >> 4, h = n & 15, k0 = kc * 8; float v[8];
            if (k0 < 512) { const int s = kc >> 1, h0 = (kc & 1) * 8;
#pragma unroll
                for (int i = 0; i < 8; ++i) { const int hp = h0 + i; float t = 0.f; if (s <= tau) t += Kt[(tau - s) * 256 + h * 16 + hp]; if (s >= tau) t += Kt[(32 + s - tau) * 256 + h * 16 + hp];
                    if (s == tau && h == hp) t += dd[g * 16 + h]; v[i] = t; }
            } else { const int r = k0 >= 640 ? 1 : 0, rel = k0 - (r ? 640 : 512), im = rel >> 6, p0 = rel & 63, e = r ? 32 - tau : tau + 1;
#pragma unroll
                for (int i = 0; i < 8; ++i) { const cf z = cmul(Cc[(r * 16 + h) * 64 + p0 + i], apow[(r * 33 + e) * 64 + p0 + i]); v[i] = im ? -z.y : z.x; } }
            u32x4 o; o.x = cvt_pk_bf16(v[0], v[1]); o.y = cvt_pk_bf16(v[2], v[3]); o.z = cvt_pk_bf16(v[4], v[5]); o.w = cvt_pk_bf16(v[6], v[7]);
            *(u32x4*)(W3 + ((size_t)(g * 512 + n) * KS3 + k0)) = o; }
    }
    __syncthreads();
}

struct Args { const float* in[26]; float* out; unsigned char* ws; int ph_lo, ph_hi, li, pad; };
constexpr int N_PHASES = 19;
#ifndef MK_N_LAUNCHES
#define MK_N_LAUNCHES 1
#endif

__global__ void __launch_bounds__(NWAVES * 64, 2) trunk_fwd(Args args) {
    extern __shared__ __attribute__((aligned(16))) unsigned char lds_raw[];
    LAS unsigned char* lds = (LAS unsigned char*)lds_raw;
    volatile LAS unsigned* MISC = (volatile LAS unsigned*)(lds + MISC_OFF);
    const int G = gridDim.x, bx = blockIdx.x, vcu = (G % 8 == 0) ? (bx % 8) * (G / 8) + bx / 8 : bx, NGW = G * NWAVES;
#define PHASE_IDS int tid = threadIdx.x; asm volatile("" : "+v"(tid)); const int lane = tid & 63, wave = __builtin_amdgcn_readfirstlane(tid >> 6), gw = vcu * NWAVES + wave; (void)lane; (void)gw;
    unsigned char* ws = args.ws;
    unsigned* ctl = (unsigned*)(ws + WS_CTL);
    if (threadIdx.x < 64) MISC[threadIdx.x] = 0u;
    __syncthreads();
    XcdBarrier bar; bar.bar = ctl + CW_BAR; bar.x = 0; bar.st = nullptr;
    if (MK_N_LAUNCHES == 1) bar = xcd_barrier_post(ctl + CW_BAR, MISC + 8);
    const int lo = args.ph_lo, hi = args.ph_hi;
#ifndef PH_MASK
#define PH_MASK 0xFFFFFFFFu
#endif
#define IN(k) (((PH_MASK >> (((k) >= 14 && (k) <= 17) ? (k) - 7 : (k))) & 1u) && lo <= (k) && (k) < hi)
#define SEAM(k) do { if (lo <= (k) && (k) + 1 < hi) xcd_barrier(bar); } while (0)

    const float* x = args.in[0]; const float* mem = args.in[1]; const float* norm_mix = args.in[2]; const float* norm_xattn = args.in[3]; const float* norm_mem = args.in[4];
    const float* norm_ffn = args.in[5]; const float* norm_final = args.in[6];
    float* H = args.out;
    bf16_t* WinT = (bf16_t*)(ws + WS_WINT); bf16_t* WgluT = (bf16_t*)(ws + WS_WGLUT); bf16_t* WoutT = (bf16_t*)(ws + WS_WOUTT); bf16_t* BinT = (bf16_t*)(ws + WS_BINT); bf16_t* BoutT = (bf16_t*)(ws + WS_BOUTT);
    bf16_t* WqN = (bf16_t*)(ws + WS_WQN); bf16_t* WoT = (bf16_t*)(ws + WS_WOT); bf16_t* WkvT = (bf16_t*)(ws + WS_WKVT); bf16_t* W1T = (bf16_t*)(ws + WS_W1T); bf16_t* W2T = (bf16_t*)(ws + WS_W2T);
    bf16_t* memn = (bf16_t*)(ws + WS_MEMN); bf16_t* KV = (bf16_t*)(ws + WS_KV); bf16_t* WeffT = (bf16_t*)(ws + WS_WEFFT); bf16_t* VWT = (bf16_t*)(ws + WS_VWT);
    bf16_t* Hb = (bf16_t*)(ws + WS_HB); float* ssqp = (float*)(ws + WS_SSQP);
    bf16_t* WSs = (bf16_t*)(ws + WS_WS); bf16_t* W3 = (bf16_t*)(ws + WS_W3); bf16_t* UX = (bf16_t*)(ws + WS_UX); float* Ssum = (float*)(ws + WS_S); bf16_t* Zgm = (bf16_t*)(ws + WS_ZGM);
    bf16_t* Z2 = (bf16_t*)(ws + WS_Z2); bf16_t* Pm = (bf16_t*)(ws + WS_P); bf16_t* Aff = (bf16_t*)(ws + WS_AFF); bf16_t* Zbv = (bf16_t*)(ws + WS_ZBV); bf16_t* Cg = (bf16_t*)(ws + WS_CG); bf16_t* Zc = (bf16_t*)(ws + WS_ZC);
    constexpr int BIG = 1 << 30;
    constexpr long TS2K = 256L * 2048;

    if (IN(0)) {
        PHASE_IDS
        for (int it = vcu; it < 4 * NG; it += G)
            ssm_tables(lds, it >> 2, it & 3, args.in[8], args.in[9], args.in[10], args.in[11], args.in[12], args.in[13], args.in[14], args.in[15], WSs, W3);
        __syncthreads();
        LAS float* scr = (LAS float*)(lds + wave * 16384);
        constexpr int I_DD = 16 * 32, I_BIN = 16 * 96, I_KV = 16 * 64, I_W1 = 16 * 128, I_W2 = 64 * 32;
        constexpr int NITEMS = 3 * I_DD + I_BIN + I_DD + 2 * I_DD + 2 * I_KV + 2 * I_W1 + 2 * I_W2;
        for (int it = gw; it < NITEMS; it += NGW) {
            int r = it;
            if (transpose_job(r, args.in[7], D, D, norm_mix, WinT, 0, scr, lane)) continue;
            if (transpose_job(r, args.in[16], D, D, nullptr, WgluT, 0, scr, lane)) continue;
            if (transpose_job(r, args.in[17], D, D, nullptr, WoutT, 0, scr, lane)) continue;
            if (transpose_job(r, args.in[18], D, 3 * D, norm_mix + D, BinT, 1, scr, lane)) continue;
            if (transpose_job(r, args.in[20], D, D, nullptr, BoutT, 0, scr, lane)) continue;
            if (transpose_job(r, args.in[23], D, D, nullptr, WoT, 0, scr, lane)) continue;
            if (transpose_job(r, args.in[23] + (size_t)D * D, D, D, nullptr, WoT + (size_t)D * D, 0, scr, lane)) continue;
            if (transpose_job(r, args.in[22], D, 2 * D, norm_mem, WkvT, 0, scr, lane)) continue;
            if (transpose_job(r, args.in[22] + (size_t)D * 2 * D, D, 2 * D, norm_mem + D, WkvT + (size_t)2 * D * D, 0, scr, lane)) continue;
            if (transpose_job(r, args.in[24], D, FF, norm_ffn, W1T, 0, scr, lane)) continue;
            if (transpose_job(r, args.in[24] + (size_t)D * FF, D, FF, norm_ffn + D, W1T + (size_t)FF * D, 0, scr, lane)) continue;
            if (transpose_job(r, args.in[25], FF, D, nullptr, W2T, 0, scr, lane)) continue;
            transpose_job(r, args.in[25] + (size_t)FF * D, FF, D, nullptr, W2T + (size_t)D * FF, 0, scr, lane);
        }
        for (int rw = gw; rw < 2 * D; rw += NGW) { const float gsc = norm_xattn[rw] * 0.0625f; const f32x4* src = (const f32x4*)(args.in[21] + (size_t)rw * D) + lane; u32x2* dst = (u32x2*)(WqN + (size_t)rw * D) + lane;
#pragma unroll
            for (int j = 0; j < 4; ++j) { const f32x4 v = src[64 * j] * gsc; u32x2 o; o.x = cvt_pk_bf16(v[0], v[1]); o.y = cvt_pk_bf16(v[2], v[3]); dst[64 * j] = o; } }
        for (int t = gw; t < T; t += NGW) { const f32x4* src = (const f32x4*)(x + (size_t)t * D) + lane; u32x2* dst = (u32x2*)(Hb + (size_t)t * D) + lane; float s = 0.f;
#pragma unroll
            for (int j = 0; j < 4; ++j) { const f32x4 v = src[64 * j]; s += (v[0] * v[0] + v[1] * v[1]) + (v[2] * v[2] + v[3] * v[3]); u32x2 o; o.x = cvt_pk_bf16(v[0], v[1]); o.y = cvt_pk_bf16(v[2], v[3]); dst[64 * j] = o; }
            s = wave_sum(s); if (lane < 16) ssqp[(size_t)t * 16 + lane] = lane == 0 ? s : 0.f; }
        for (int t = gw; t < MEMT; t += NGW) { const f32x4* src = (const f32x4*)(mem + (size_t)t * D) + lane; u32x2* dst = (u32x2*)(memn + (size_t)t * D) + lane; f32x4 v[4]; float s = 0.f;
#pragma unroll
            for (int j = 0; j < 4; ++j) { v[j] = src[64 * j]; s += (v[j][0] * v[j][0] + v[j][1] * v[j][1]) + (v[j][2] * v[j][2] + v[j][3] * v[j][3]); }
            const float ri = __builtin_amdgcn_rsqf(wave_sum(s) * (1.0f / D) + EPS);
#pragma unroll
            for (int j = 0; j < 4; ++j) { u32x2 o; o.x = cvt_pk_bf16(v[j][0] * ri, v[j][1] * ri); o.y = cvt_pk_bf16(v[j][2] * ri, v[j][3] * ri); dst[64 * j] = o; } }
        SEAM(0);
    }
    if (IN(1)) {
        { pg8::Gemm g{Hb, WinT, D, 2048u, 32u, 128u, 2048u}; pg8::Order<pg8::MapG> S; S.init(T / 256, D / 256, G, bx, pg8::MapG{TS2K, TS2K, BIG, 0, BIG});
          pg8::EpiU E{UX, ssqp}; pg8::gemm_phase(lds, g, S, E); }
        { pg8::Gemm g{memn, WkvT, D, 2048u, 32u, 128u, 2048u}; pg8::Order<pg8::MapG> S; S.init(8, 8, G, bx, pg8::MapG{TS2K, TS2K, 4, 8, 4});
          pg8::EpiBf16Plain E{KV, 2 * D}; pg8::gemm_phase(lds, g, S, E); }
        SEAM(1);
    }
    if (IN(2)) {
        { pg8::Gemm g{UX, WSs, KS1, KS3 * 2u, 32u, 128u, KS1 * 2u}; pg8::Order<pg8::MapG> S; S.init(NG * NCH / 256, 1, G, bx, pg8::MapG{256L * KS3 * 2, 256L * KS1 * 2, 4, 1, BIG});
          pg8::EpiF32Plain E{Ssum, 256}; pg8::gemm_phase(lds, g, S, E); }
        struct MapWeff { __device__ __forceinline__ void map(int pm, int pn, pg8::Unit& u) const { u.pm = pm; u.pn = pn;
            u.aoff = ((long)(pm >> 2) * 256 * 2048 + (pm & 3) * 256) * 2; u.boff = ((long)(pm >> 4) * D * D + (long)pn * 256 * D + (pm & 3) * 256) * 2; } };
        { pg8::Gemm g{KV, WqN, 256, 4096u, 32u, 128u, 2048u}; pg8::Order<MapWeff> S; S.init(32, 4, G, bx, MapWeff{});
          pg8::EpiBf16Plain E{WeffT, D}; pg8::gemm_phase(lds, g, S, E); }
        struct MapVW { __device__ __forceinline__ void map(int pm, int pn, pg8::Unit& u) const { u.pm = pm; u.pn = pn;
            u.aoff = ((long)(pm >> 4) * D * D + (long)(pm & 3) * 256 * D + pn * 256) * 2; u.boff = ((long)(pm >> 2) * 256 * 2048 + 1024 + pn * 256) * 2; } };
        { pg8::Gemm g{WoT, KV, 256, 2048u, 32u, 128u, 4096u}; pg8::Order<MapVW> S; S.init(32, 4, G, bx, MapVW{});
          pg8::EpiBf16Plain E{VWT, D}; pg8::gemm_phase(lds, g, S, E); }
        SEAM(2);
    }
    if (IN(3)) {
        PHASE_IDS
        for (int it = vcu; it < NB * NG; it += G) {
            const int b = it & 3, g = it >> 2;
            if (wave < 2) {
                const int r = wave, p = lane; const int gi = (r * 64 + g) * 64 + p;
                const float lr = args.in[8][gi], li = args.in[9][gi], dt = expf(args.in[10][r * 64 + g]);
                const float mag = expf(32.0f * lr * dt), ang = 32.0f * li * dt; const float ax = mag * cosf(ang), ay = mag * sinf(ang);
                float X = 0.f, Y = 0.f;
                const size_t row0 = (size_t)g * NCH + (size_t)b * NCHB;
                for (int c0 = 0; c0 < NCHB; c0 += 8) {
                    float sx[8], sy[8];
#pragma unroll
                    for (int i = 0; i < 8; ++i) { const int c = r == 0 ? c0 + i : NCHB - 1 - (c0 + i); const float* sp = Ssum + (row0 + c) * 256 + r * 128 + p; sx[i] = sp[0]; sy[i] = sp[64]; }
#pragma unroll
                    for (int i = 0; i < 8; ++i) { const int c = r == 0 ? c0 + i : NCHB - 1 - (c0 + i); bf16_t* up = UX + (row0 + c) * KS3 + KS1 + r * 128 + p;
                        const unsigned w = cvt_pk_bf16(X, Y); up[0] = (bf16_t)(w & 0xffffu); up[64] = (bf16_t)(w >> 16);
                        const float nX = ax * X - ay * Y + sx[i], nY = ax * Y + ay * X + sy[i]; X = nX; Y = nY; }
                }
            }
        }
        SEAM(3);
    }
    if (IN(4)) {
        pg8::Gemm g{UX, W3, KS3, KS3 * 2u, 32u, 128u, KS3 * 2u}; pg8::Order<pg8::MapG> S; S.init(NG * NCH / 256, 2, G, bx, pg8::MapG{256L * KS3 * 2, 256L * KS3 * 2, 4, 2, BIG});
        pg8::EpiGelu E{Zgm}; pg8::gemm_phase(lds, g, S, E);
        SEAM(4);
    }
    if (IN(5)) {
        pg8::Gemm g{Zgm, WgluT, D, 32u, (unsigned)T * 32u, 4u * (unsigned)T * 32u, 2048u}; pg8::Order<pg8::MapG> S; S.init(T / 256, D / 256, G, bx, pg8::MapG{256L * 32, TS2K, BIG, 0, BIG});
        pg8::EpiGlu E{Zgm, Z2}; pg8::gemm_phase(lds, g, S, E);
        SEAM(5);
    }
    if (IN(6)) {
        pg8::Gemm g{Z2, WoutT, D, 2048u, 32u, 128u, 2048u}; pg8::Order<pg8::MapG> S; S.init(T / 256, D / 256, G, bx, pg8::MapG{TS2K, TS2K, BIG, 0, BIG});
        pg8::EpiRes E{x, H, Hb, ssqp}; pg8::gemm_phase(lds, g, S, E);
        SEAM(6);
    }
    for (int layer = 0; layer < 2; ++layer) {
        if (layer == 1) {
            if (IN(11)) {
                pg8::Gemm g{Hb, BinT, D, 2048u, 32u, 128u, 2048u}; pg8::Order<pg8::MapG> S; S.init(T / 256, 12, G, bx, pg8::MapG{TS2K, TS2K, BIG, 0, BIG});
                pg8::EpiBCV E{Zbv, Cg, ssqp}; pg8::gemm_phase(lds, g, S, E);
                SEAM(11);
            }
            if (IN(12)) {
                PHASE_IDS
                const float* cw = args.in[19];
                f32x4 w0[4], w1[4], w2[4];
#pragma unroll
                for (int j = 0; j < 4; ++j) { w0[j] = *(const f32x4*)(cw + 16 * lane + 4 * j); w1[j] = *(const f32x4*)(cw + D + 16 * lane + 4 * j); w2[j] = *(const f32x4*)(cw + 2 * D + 16 * lane + 4 * j); }
                for (int blk = gw; blk < T / 16; blk += NGW) {
                    const int t0 = blk * 16; f32x4 pv[4], cv[4], nv[4];
                    if ((t0 & (SEQ - 1)) == 0) {
#pragma unroll
                        for (int j = 0; j < 4; ++j) pv[j] = (f32x4){0.f, 0.f, 0.f, 0.f};
                    } else { const u32x4* zp = (const u32x4*)(Zbv + (size_t)(t0 - 1) * D + 16 * lane); pg8::unpack8(zp[0], pv[0], pv[1]); pg8::unpack8(zp[1], pv[2], pv[3]); }
                    { const u32x4* zp = (const u32x4*)(Zbv + (size_t)t0 * D + 16 * lane); pg8::unpack8(zp[0], cv[0], cv[1]); pg8::unpack8(zp[1], cv[2], cv[3]); }
                    for (int i = 0; i < 16; ++i) { const int t = t0 + i;
                        if ((t & (SEQ - 1)) == SEQ - 1) {
#pragma unroll
                            for (int j = 0; j < 4; ++j) nv[j] = (f32x4){0.f, 0.f, 0.f, 0.f};
                        } else { const u32x4* zp = (const u32x4*)(Zbv + (size_t)(t + 1) * D + 16 * lane); pg8::unpack8(zp[0], nv[0], nv[1]); pg8::unpack8(zp[1], nv[2], nv[3]); }
                        const u32x4* cp = (const u32x4*)(Cg + (size_t)t * D + 16 * lane); f32x4 gc[4]; pg8::unpack8(cp[0], gc[0], gc[1]); pg8::unpack8(cp[1], gc[2], gc[3]);
                        f32x4 o[4];
#pragma unroll
                        for (int j = 0; j < 4; ++j) { o[j] = gc[j] * (w0[j] * pv[j] + w1[j] * cv[j] + w2[j] * nv[j]); pv[j] = cv[j]; cv[j] = nv[j]; }
                        u32x4* op = (u32x4*)(Zc + (size_t)t * D + 16 * lane); op[0] = pg8::pack8(o[0], o[1]); op[1] = pg8::pack8(o[2], o[3]); }
                }
                SEAM(12);
            }
            if (IN(13)) {
                pg8::Gemm g{Zc, BoutT, D, 2048u, 32u, 128u, 2048u}; pg8::Order<pg8::MapG> S; S.init(T / 256, D / 256, G, bx, pg8::MapG{TS2K, TS2K, BIG, 0, BIG});
                pg8::EpiRes E{H, H, Hb, ssqp}; pg8::gemm_phase(lds, g, S, E);
                SEAM(13);
            }
        }
        const int pb = layer ? 14 : 7;
        if (IN(pb)) {
            pg8::Gemm g{Hb, WeffT + (size_t)layer * NB * D * D, D, 2048u, 32u, 128u, 2048u}; pg8::Order<pg8::MapG> S; S.init(T / 256, D / 256, G, bx, pg8::MapG{TS2K, TS2K, SEQ / 256, 4, BIG});
            pg8::EpiSoftmax E{Pm, ssqp, (LAS f32x2*)(lds + XCH_OFF)}; pg8::gemm_phase(lds, g, S, E);
            SEAM(pb);
        }
        if (IN(pb + 1)) {
            pg8::Gemm g{Pm, VWT + (size_t)layer * NB * D * D, D, 2048u, 32u, 128u, 2048u}; pg8::Order<pg8::MapG> S; S.init(T / 256, D / 256, G, bx, pg8::MapG{TS2K, TS2K, SEQ / 256, 4, BIG});
            pg8::EpiRes E{H, H, Hb, ssqp}; pg8::gemm_phase(lds, g, S, E);
            SEAM(pb + 1);
        }
        if (IN(pb + 2)) {
            pg8::Gemm g{Hb, W1T + (size_t)layer * FF * D, D, 2048u, 32u, 128u, 2048u}; pg8::Order<pg8::MapG> S; S.init(T / 256, FF / 256, G, bx, pg8::MapG{TS2K, TS2K, BIG, 0, BIG});
            pg8::EpiRelu2 E{Aff, ssqp}; pg8::gemm_phase(lds, g, S, E);
            SEAM(pb + 2);
        }
        if (IN(pb + 3)) {
            pg8::Gemm g{Aff, W2T + (size_t)layer * D * FF, FF, 8192u, 32u, 128u, 8192u}; pg8::Order<pg8::MapG> S; S.init(T / 256, D / 256, G, bx, pg8::MapG{256L * 8192, 256L * 8192, BIG, 0, BIG});
            pg8::EpiRes E{H, H, Hb, ssqp}; pg8::gemm_phase(lds, g, S, E);
            SEAM(pb + 3);
        }
    }
    if (IN(18)) {
        PHASE_IDS
        f32x4 gn[4];
#pragma unroll
        for (int j = 0; j < 4; ++j) gn[j] = ((const f32x4*)norm_final)[lane + 64 * j];
        for (int t = gw; t < T; t += NGW) { const float ri = pg8::row_rinv(ssqp, t); f32x4* hp = (f32x4*)(H + (size_t)t * D) + lane;
#pragma unroll
            for (int j = 0; j < 4; ++j) hp[64 * j] = hp[64 * j] * gn[j] * ri; }
    }
#undef IN
#undef SEAM
}

extern "C" void kernel_launch(void* const* d_in, const int* in_sizes, int n_in, void* d_out, int out_size, void* d_ws, size_t ws_size, hipStream_t stream) {
    static int grid = 0;
    if (grid == 0) {
        if (n_in != 26 || in_sizes[0] != T * D || out_size != T * D || ws_size < WS_END) {
            fprintf(stderr, "kernel_launch: built for 26 inputs, x/out of %d floats, >= %zu bytes of workspace; got n_in %d, in0 %d, out %d, ws %zu; nothing launched\n", T * D, (size_t)WS_END, n_in, n_in > 0 ? in_sizes[0] : -1, out_size, ws_size);
            grid = -1; return; }
        int dev = 0, cus = 0, per_cu = 0;
        if (hipGetDevice(&dev) != hipSuccess || hipDeviceGetAttribute(&cus, hipDeviceAttributeMultiprocessorCount, dev) != hipSuccess) { fprintf(stderr, "kernel_launch: device query failed\n"); grid = -1; return; }
        if (hipFuncSetAttribute((const void*)trunk_fwd, hipFuncAttributeMaxDynamicSharedMemorySize, LDS_BYTES) != hipSuccess) { fprintf(stderr, "kernel_launch: hipFuncSetAttribute failed\n"); grid = -1; return; }
        if (hipOccupancyMaxActiveBlocksPerMultiprocessor(&per_cu, (const void*)trunk_fwd, NWAVES * 64, LDS_BYTES) != hipSuccess || per_cu < 1)
            fprintf(stderr, "kernel_launch: note: occupancy query reports %d workgroups per CU\n", per_cu);
        (void)hipGetLastError();
        grid = cus;
    }
    if (grid < 0) return;
    if (hipMemsetAsync((char*)d_ws + WS_CTL, 0, CTL_ZERO_BYTES, stream) != hipSuccess) { fprintf(stderr, "kernel_launch: hipMemsetAsync failed\n"); return; }
    Args a{};
    for (int i = 0; i < 26; ++i) a.in[i] = (const float*)d_in[i];
    a.out = (float*)d_out; a.ws = (unsigned char*)d_ws;
#if MK_N_LAUNCHES == 1
    a.ph_lo = 0; a.ph_hi = N_PHASES; a.li = 0;
    void* kargs[] = {&a};
    hipError_t e = hipLaunchCooperativeKernel((const void*)trunk_fwd, dim3(grid), dim3(NWAVES * 64), kargs, LDS_BYTES, stream);
    if (e != hipSuccess) { fprintf(stderr, "kernel_launch: cooperative launch failed: %s (grid %d)\n", hipGetErrorString(e), grid); (void)hipGetLastError();
        hipLaunchKernelGGL(trunk_fwd, dim3(grid), dim3(NWAVES * 64), LDS_BYTES, stream, a); }
#else
    for (int ph = 0; ph < N_PHASES; ++ph) { a.ph_lo = ph; a.ph_hi = ph + 1; a.li = ph; hipLaunchKernelGGL(trunk_fwd, dim3(grid), dim3(NWAVES * 64), LDS_BYTES, stream, a); }
#endif
}
```

```cpp
#include <hip/hip_runtime.h>
#include <cstdio>
#include <cstdint>

#define LAS __attribute__((address_space(3)))
#define GAS __attribute__((address_space(1)))
typedef unsigned short bf16_t;
typedef short bf16x8 __attribute__((ext_vector_type(8)));
typedef float f32x4 __attribute__((ext_vector_type(4)));
typedef float f32x2 __attribute__((ext_vector_type(2)));
typedef unsigned u32x4 __attribute__((ext_vector_type(4)));
typedef unsigned u32x2 __attribute__((ext_vector_type(2)));

constexpr int T = 32768, D = 1024, FF = 4096, SEQ = 8192, NB = 4, MEMT = 1024, MEML = 256;
constexpr int NG = 64, CN = 32, NCH = T / CN, NCHB = SEQ / CN, KS1 = CN * 16, KS3 = CN * 16 + 256;
constexpr float EPS = 1e-6f;

namespace pg8 {
constexpr int BM = 256, BK = 64, HALF = 128, HTB = HALF * BK * 2, STAGE_BYTES = 8 * HTB, NXCD = 8, WGM = 8;
__host__ __device__ __forceinline__ int lds_byte(int r, int c) { const int st = (r >> 4) * 2 + (c >> 5), rr = r & 15, cc = c & 31, ob = rr * 64 + cc * 2; return st * 1024 + (ob ^ (((ob >> 9) & 1) << 5)); }
__host__ __device__ __forceinline__ void stage_rc(int b, int& R, int& C) { const int st = b / 1024, sb = b % 1024, swz = sb ^ (((sb >> 9) & 1) << 5); R = (st >> 1) * 16 + swz / 64; C = (st & 1) * 32 + (swz % 64) / 2; }
__host__ __device__ __forceinline__ int perm32(int rho) { const int n = rho >> 4, i = rho & 15; return 8 * (i >> 2) + 4 * n + (i & 3); }

struct Unit { int pm, pn; long aoff, boff; };
struct Gemm { const bf16_t* A; const bf16_t* Bt; int K; unsigned a_rs, a_c16, a_kstep, b_rs; };

template <class Map> struct Order {
    int nM, nN, nwg, G, c; Map mp;
    __device__ __forceinline__ void init(int nM_, int nN_, int G_, int c_, const Map& m) { nM = nM_; nN = nN_; nwg = nM * nN; G = G_; c = c_; mp = m; }
    __device__ __forceinline__ bool next(int i, Unit& u) const {
        const long L = (long)i * G + c; if (L >= nwg) return false;
        int wgid = (int)L; { const int q = nwg / NXCD, r = nwg % NXCD, xcd = wgid % NXCD, off = wgid / NXCD; wgid = (xcd < r ? xcd * (q + 1) : r * (q + 1) + (xcd - r) * q) + off; }
        const int nig = WGM * nN, gid = wgid / nig, fm = gid * WGM, gsz = (nM - fm) < WGM ? (nM - fm) : WGM;
        const int pm = fm + ((wgid % nig) % gsz), pn = (wgid % nig) / gsz;
        mp.map(pm, pn, u); return true;
    }
};
struct MapG { long a_t, b_t; int grp_m, nNb, a_mod;
    __device__ __forceinline__ void map(int pm, int pn, Unit& u) const { u.pm = pm; u.pn = pn; u.aoff = (long)(pm % a_mod) * a_t; u.boff = (long)((pm / grp_m) * nNb + pn) * b_t; } };

__device__ __forceinline__ unsigned cvt_pk_bf16(float lo, float hi) { unsigned r; asm volatile("v_cvt_pk_bf16_f32 %0, %1, %2" : "=v"(r) : "v"(lo), "v"(hi)); return r; }
__device__ __forceinline__ u32x4 pack8(const f32x4 a, const f32x4 b) { u32x4 w; w.x = cvt_pk_bf16(a[0], a[1]); w.y = cvt_pk_bf16(a[2], a[3]); w.z = cvt_pk_bf16(b[0], b[1]); w.w = cvt_pk_bf16(b[2], b[3]); return w; }
__device__ __forceinline__ void unpack8(const u32x4 w, f32x4& a, f32x4& b) {
    a[0] = __uint_as_float(w.x << 16); a[1] = __uint_as_float(w.x & 0xffff0000u); a[2] = __uint_as_float(w.y << 16); a[3] = __uint_as_float(w.y & 0xffff0000u);
    b[0] = __uint_as_float(w.z << 16); b[1] = __uint_as_float(w.z & 0xffff0000u); b[2] = __uint_as_float(w.w << 16); b[3] = __uint_as_float(w.w & 0xffff0000u); }
__device__ __forceinline__ float row_rinv(const float* ssqp, int row) {
    const f32x4* p = (const f32x4*)(ssqp + (size_t)row * 16); const f32x4 a = p[0], b = p[1], c = p[2], d = p[3];
    const f32x4 s = (a + b) + (c + d); return __builtin_amdgcn_rsqf(((s[0] + s[1]) + (s[2] + s[3])) * (1.0f / 1024.0f) + EPS); }

#define EPI_ROWS_BEGIN _Pragma("unroll") for (int ai = 0; ai < 2; ++ai) _Pragma("unroll") for (int m = 0; m < 4; ++m) { const int rt = ai * 128 + wr * 64 + m * 16 + fr; const int row = u.pm * 256 + rt; (void)row;
#define EPI_ROWS_END }
#define EPI_COLS_BEGIN _Pragma("unroll") for (int bj = 0; bj < 2; ++bj) { const int ct = bj * 128 + wc * 32 + 8 * fq; (void)ct;
#define EPI_COLS_END }

struct EpiBf16Plain {
    bf16_t* O; int ldc;
    __device__ __forceinline__ void operator()(f32x4 (&acc)[2][2][4][2], const Unit& u, int wr, int wc, int fr, int fq) const {
        EPI_ROWS_BEGIN bf16_t* rowp = O + (size_t)row * ldc + u.pn * 256;
        EPI_COLS_BEGIN *(u32x4*)(rowp + ct) = pack8(acc[ai][bj][m][0], acc[ai][bj][m][1]); EPI_COLS_END
        EPI_ROWS_END }
};
struct EpiF32Plain {
    float* O; int ldc;
    __device__ __forceinline__ void operator()(f32x4 (&acc)[2][2][4][2], const Unit& u, int wr, int wc, int fr, int fq) const {
        EPI_ROWS_BEGIN float* rowp = O + (size_t)row * ldc + u.pn * 256;
        EPI_COLS_BEGIN *(f32x4*)(rowp + ct) = acc[ai][bj][m][0]; *(f32x4*)(rowp + ct + 4) = acc[ai][bj][m][1]; EPI_COLS_END
        EPI_ROWS_END }
};
struct EpiU {
    bf16_t* UX; const float* ssqp;
    __device__ __forceinline__ void operator()(f32x4 (&acc)[2][2][4][2], const Unit& u, int wr, int wc, int fr, int fq) const {
        EPI_ROWS_BEGIN const float ri = row_rinv(ssqp, row); const int ch = row >> 5, tau = row & 31;
        EPI_COLS_BEGIN const int col = u.pn * 256 + ct, g = col >> 4, h0 = col & 15;
            *(u32x4*)(UX + ((size_t)g * NCH + ch) * KS3 + tau * 16 + h0) = pack8(acc[ai][bj][m][0] * ri, acc[ai][bj][m][1] * ri); EPI_COLS_END
        EPI_ROWS_END }
};
__device__ __forceinline__ float gelu_tanh(float x) {
    const float t = x * (0.7978845608f + 0.0356774081f * x * x);
    return x * __builtin_amdgcn_rcpf(1.0f + __builtin_amdgcn_exp2f(-2.8853900818f * t)); }
__device__ __forceinline__ float sigmoidf_(float x) { return __builtin_amdgcn_rcpf(1.0f + __builtin_amdgcn_exp2f(-1.4426950409f * x)); }
struct EpiGelu {
    bf16_t* O;
    __device__ __forceinline__ void operator()(f32x4 (&acc)[2][2][4][2], const Unit& u, int wr, int wc, int fr, int fq) const {
        EPI_ROWS_BEGIN bf16_t* rowp = O + (size_t)row * 512 + u.pn * 256;
        EPI_COLS_BEGIN f32x4 a = acc[ai][bj][m][0], b = acc[ai][bj][m][1];
#pragma unroll
            for (int e = 0; e < 4; ++e) { a[e] = gelu_tanh(a[e]); b[e] = gelu_tanh(b[e]); }
            *(u32x4*)(rowp + ct) = pack8(a, b); EPI_COLS_END
        EPI_ROWS_END }
};
struct EpiGlu {
    const bf16_t* Zgm; bf16_t* Z2;
    __device__ __forceinline__ void operator()(f32x4 (&acc)[2][2][4][2], const Unit& u, int wr, int wc, int fr, int fq) const {
        EPI_ROWS_BEGIN
        EPI_COLS_BEGIN const int col = u.pn * 256 + ct; const u32x4 zw = *(const u32x4*)(Zgm + ((size_t)(col >> 4) * T + row) * 16 + (col & 15));
            f32x4 za, zb; unpack8(zw, za, zb); f32x4 a = acc[ai][bj][m][0], b = acc[ai][bj][m][1];
#pragma unroll
            for (int e = 0; e < 4; ++e) { a[e] = za[e] * sigmoidf_(a[e]); b[e] = zb[e] * sigmoidf_(b[e]); }
            *(u32x4*)(Z2 + (size_t)row * D + col) = pack8(a, b); EPI_COLS_END
        EPI_ROWS_END }
};
struct EpiRes {
    bf16_t* Hb; float* ssqp;
    __device__ __forceinline__ void operator()(f32x4 (&acc)[2][2][4][2], const Unit& u, int wr, int wc, int fr, int fq) const {
        EPI_ROWS_BEGIN float ss = 0.f;
        EPI_COLS_BEGIN bf16_t* hp = Hb + (size_t)row * D + u.pn * 256 + ct; f32x4 ha, hb; unpack8(*(const u32x4*)hp, ha, hb);
            const f32x4 a = ha + acc[ai][bj][m][0], b = hb + acc[ai][bj][m][1];
            *(u32x4*)hp = pack8(a, b);
            ss += (a[0] * a[0] + a[1] * a[1]) + (a[2] * a[2] + a[3] * a[3]) + (b[0] * b[0] + b[1] * b[1]) + (b[2] * b[2] + b[3] * b[3]); EPI_COLS_END
            ss += __shfl_xor(ss, 16); ss += __shfl_xor(ss, 32);
            if (fq == 0) ssqp[(size_t)row * 16 + u.pn * 4 + wc] = ss;
        EPI_ROWS_END }
};
struct EpiRelu2 {
    bf16_t* O; const float* ssqp;
    __device__ __forceinline__ void operator()(f32x4 (&acc)[2][2][4][2], const Unit& u, int wr, int wc, int fr, int fq) const {
        EPI_ROWS_BEGIN const float ri = row_rinv(ssqp, row); bf16_t* rowp = O + (size_t)row * FF + u.pn * 256;
        EPI_COLS_BEGIN f32x4 a = acc[ai][bj][m][0] * ri, b = acc[ai][bj][m][1] * ri;
#pragma unroll
            for (int e = 0; e < 4; ++e) { a[e] = fmaxf(a[e], 0.f); a[e] *= a[e]; b[e] = fmaxf(b[e], 0.f); b[e] *= b[e]; }
            *(u32x4*)(rowp + ct) = pack8(a, b); EPI_COLS_END
        EPI_ROWS_END }
};
struct EpiBCV {
    bf16_t* Zbv; bf16_t* Cg; const float* ssqp;
    __device__ __forceinline__ void operator()(f32x4 (&acc)[2][2][4][2], const Unit& u, int wr, int wc, int fr, int fq) const {
        if (u.pn < 8) {
            EPI_ROWS_BEGIN const float ri = row_rinv(ssqp, row), r2 = ri * ri;
                *(u32x4*)(Zbv + (size_t)row * D + u.pn * 128 + wc * 32 + 8 * fq) = pack8(acc[ai][0][m][0] * acc[ai][1][m][0] * r2, acc[ai][0][m][1] * acc[ai][1][m][1] * r2);
            EPI_ROWS_END
        } else {
            EPI_ROWS_BEGIN const float ri = row_rinv(ssqp, row); bf16_t* rowp = Cg + (size_t)row * D + (u.pn - 8) * 256;
            EPI_COLS_BEGIN *(u32x4*)(rowp + ct) = pack8(acc[ai][bj][m][0] * ri, acc[ai][bj][m][1] * ri); EPI_COLS_END
            EPI_ROWS_END
        }
    }
};
struct EpiSoftmax {
    bf16_t* P; const float* ssqp; LAS f32x2* xch;
    __device__ __forceinline__ void operator()(f32x4 (&acc)[2][2][4][2], const Unit& u, int wr, int wc, int fr, int fq) const {
        float mw[2][4];
        EPI_ROWS_BEGIN const float ri = row_rinv(ssqp, row) * 1.4426950409f; float mx = -3.0e38f;
        EPI_COLS_BEGIN
#pragma unroll
            for (int n = 0; n < 2; ++n) { acc[ai][bj][m][n] = acc[ai][bj][m][n] * ri; const f32x4 v = acc[ai][bj][m][n]; mx = fmaxf(mx, fmaxf(fmaxf(v[0], v[1]), fmaxf(v[2], v[3]))); } EPI_COLS_END
            mx = fmaxf(mx, __shfl_xor(mx, 16)); mx = fmaxf(mx, __shfl_xor(mx, 32)); float sm = 0.f;
        EPI_COLS_BEGIN
#pragma unroll
            for (int n = 0; n < 2; ++n) { f32x4 v = acc[ai][bj][m][n];
#pragma unroll
                for (int e = 0; e < 4; ++e) { v[e] = __builtin_amdgcn_exp2f(v[e] - mx); sm += v[e]; } acc[ai][bj][m][n] = v; } EPI_COLS_END
            sm += __shfl_xor(sm, 16); sm += __shfl_xor(sm, 32); mw[ai][m] = mx;
            if (fq == 0) xch[rt * 4 + wc] = (f32x2){mx, sm};
        EPI_ROWS_END
        asm volatile("s_waitcnt lgkmcnt(0)" ::: "memory"); __builtin_amdgcn_s_barrier(); asm volatile("" ::: "memory");
        EPI_ROWS_BEGIN const f32x2 p0 = xch[rt * 4 + 0], p1 = xch[rt * 4 + 1], p2 = xch[rt * 4 + 2], p3 = xch[rt * 4 + 3];
            const float M = fmaxf(fmaxf(p0.x, p1.x), fmaxf(p2.x, p3.x));
            const float Ls = (p0.y * __builtin_amdgcn_exp2f(p0.x - M) + p1.y * __builtin_amdgcn_exp2f(p1.x - M)) + (p2.y * __builtin_amdgcn_exp2f(p2.x - M) + p3.y * __builtin_amdgcn_exp2f(p3.x - M));
            const float f = __builtin_amdgcn_exp2f(mw[ai][m] - M) * __builtin_amdgcn_rcpf(Ls); bf16_t* rowp = P + (size_t)row * D + u.pn * 256;
        EPI_COLS_BEGIN *(u32x4*)(rowp + ct) = pack8(acc[ai][bj][m][0] * f, acc[ai][bj][m][1] * f); EPI_COLS_END
        EPI_ROWS_END
        asm volatile("s_waitcnt lgkmcnt(0)" ::: "memory"); __builtin_amdgcn_s_barrier(); asm volatile("" ::: "memory");
    }
};

template <class Epi, class Sched>
__device__ __forceinline__ void gemm_phase(LAS unsigned char* lds, const Gemm g, const Sched& S, const Epi& E) {
    int tid = threadIdx.x; asm volatile("" : "+v"(tid));
    const int wid = __builtin_amdgcn_readfirstlane(tid >> 6), lane = tid & 63, wr = wid >> 2, wc = wid & 3, fr = lane & 15, fq = lane >> 4;
    const int nt = g.K / BK;
    unsigned voffA[2], voffB[2];
#pragma unroll
    for (int i = 0; i < 2; ++i) { int R, C; stage_rc(tid * 16 + i * 8192, R, C); const int Rb = (R & ~31) + perm32(R & 31);
        voffA[i] = (unsigned)R * g.a_rs + (unsigned)(C >> 4) * g.a_c16 + (unsigned)(C & 15) * 2u; voffB[i] = (unsigned)Rb * g.b_rs + (unsigned)C * 2u; }
    const size_t kstepA = (size_t)g.a_kstep, kstepB = (size_t)(BK * 2);
    const size_t hstepA = (size_t)HALF * g.a_rs, hstepB = (size_t)HALF * g.b_rs;
    const unsigned ldsw = (unsigned)wid * 1024u;
    const int aoff = lds_byte(wr * 64 + fr, fq * 8), boff = lds_byte(wc * 32 + fr, fq * 8);
#define PG8_SA(b, h) (((b) * 2 + (h)) * HTB)
#define PG8_SB(b, h) ((4 + (b) * 2 + (h)) * HTB)
#define PG8_STAGE(bufoff, gbase, voff) do { _Pragma("unroll") for (int _i = 0; _i < 2; ++_i) \
        __builtin_amdgcn_global_load_lds((const unsigned*)((const char*)(gbase) + (voff)[_i]), (LAS unsigned*)(lds + (bufoff) + ldsw + _i * 8192), 16, 0, 0); } while (0)
#define PG8_LDA(dst, b, h) do { _Pragma("unroll") for (int m = 0; m < 4; ++m) _Pragma("unroll") for (int k = 0; k < 2; ++k) dst[m][k] = *(const LAS bf16x8*)(lds + PG8_SA(b, h) + aoff + m * 2048 + k * 1024); } while (0)
#define PG8_LDB(dst, b, h) do { _Pragma("unroll") for (int n = 0; n < 2; ++n) _Pragma("unroll") for (int k = 0; k < 2; ++k) dst[n][k] = *(const LAS bf16x8*)(lds + PG8_SB(b, h) + boff + n * 2048 + k * 1024); } while (0)
#define PG8_MMA(ai, bj, At, Bt) do { __builtin_amdgcn_s_setprio(1); _Pragma("unroll") for (int m = 0; m < 4; ++m) _Pragma("unroll") for (int n = 0; n < 2; ++n) _Pragma("unroll") for (int k = 0; k < 2; ++k) \
        acc[ai][bj][m][n] = __builtin_amdgcn_mfma_f32_16x16x32_bf16(Bt[n][k], At[m][k], acc[ai][bj][m][n], 0, 0, 0); __builtin_amdgcn_s_setprio(0); } while (0)
#define PG8_WAIT_V(n) asm volatile("s_waitcnt vmcnt(" #n ")" ::: "memory")
#define PG8_WAIT_L(n) asm volatile("s_waitcnt lgkmcnt(" #n ")" ::: "memory")
#define PG8_BAR __builtin_amdgcn_s_barrier()
#define PG8_SCHED __builtin_amdgcn_sched_barrier(0)
    Unit cur, nxt; int ui = 0;
    if (!S.next(0, cur)) return;
    f32x4 acc[2][2][4][2];
#pragma unroll
    for (int a = 0; a < 2; ++a)
#pragma unroll
        for (int b = 0; b < 2; ++b)
#pragma unroll
            for (int m = 0; m < 4; ++m)
#pragma unroll
                for (int n = 0; n < 2; ++n) acc[a][b][m][n] = (f32x4){0.f, 0.f, 0.f, 0.f};
    bf16x8 At[4][2], B0[2][2], B1[2][2];
    const char* cA = (const char*)g.A + cur.aoff; const char* cB = (const char*)g.Bt + cur.boff;
    PG8_STAGE(PG8_SB(0, 0), cB, voffB); PG8_STAGE(PG8_SB(0, 1), cB + hstepB, voffB); PG8_STAGE(PG8_SA(0, 0), cA, voffA); PG8_STAGE(PG8_SA(0, 1), cA + hstepA, voffA);
    if (wr == 1) PG8_BAR;
    PG8_WAIT_V(2); PG8_BAR;
    PG8_STAGE(PG8_SB(1, 0), cB + kstepB, voffB); PG8_STAGE(PG8_SA(1, 0), cA + kstepA, voffA); PG8_STAGE(PG8_SB(1, 1), cB + hstepB + kstepB, voffB);
    PG8_WAIT_V(6); PG8_BAR;
#pragma nounroll
    for (;;) {
        const bool has_next = S.next(ui + 1, nxt);
        const char* nA = has_next ? (const char*)g.A + nxt.aoff : cA; const char* nB = has_next ? (const char*)g.Bt + nxt.boff : cB;
#pragma nounroll
        for (int t = 0; t < nt; t += 2) {
            const bool last = (t == nt - 2);
            const char* a1 = cA + (size_t)(t + 1) * kstepA;
            const char* a2 = last ? nA : cA + (size_t)(t + 2) * kstepA; const char* b2 = last ? nB : cB + (size_t)(t + 2) * kstepB;
            const char* a3 = a2 + kstepA; const char* b3 = b2 + kstepB;
            PG8_LDB(B0, 0, 0); PG8_LDB(B1, 0, 1); PG8_SCHED; PG8_LDA(At, 0, 0); PG8_STAGE(PG8_SA(1, 1), a1 + hstepA, voffA);
            PG8_WAIT_V(8); PG8_WAIT_L(0); PG8_BAR; PG8_MMA(0, 0, At, B0); PG8_MMA(0, 1, At, B1); PG8_BAR; PG8_SCHED;
            PG8_LDA(At, 0, 1); PG8_STAGE(PG8_SB(0, 0), b2, voffB); PG8_STAGE(PG8_SB(0, 1), b2 + hstepB, voffB); PG8_STAGE(PG8_SA(0, 0), a2, voffA);
            PG8_WAIT_V(8); PG8_WAIT_L(0); PG8_BAR; PG8_MMA(1, 0, At, B0); PG8_MMA(1, 1, At, B1); PG8_BAR; PG8_SCHED;
            PG8_LDB(B0, 1, 0); PG8_LDB(B1, 1, 1); PG8_SCHED; PG8_LDA(At, 1, 0); PG8_STAGE(PG8_SA(0, 1), a2 + hstepA, voffA);
            PG8_WAIT_V(8); PG8_WAIT_L(0); PG8_BAR; PG8_MMA(0, 0, At, B0); PG8_MMA(0, 1, At, B1); PG8_BAR; PG8_SCHED;
            PG8_LDA(At, 1, 1); PG8_STAGE(PG8_SB(1, 0), b3, voffB); PG8_STAGE(PG8_SB(1, 1), b3 + hstepB, voffB); PG8_STAGE(PG8_SA(1, 0), a3, voffA);
            PG8_WAIT_V(8); PG8_WAIT_L(0); PG8_BAR; PG8_MMA(1, 0, At, B0); PG8_MMA(1, 1, At, B1); PG8_BAR; PG8_SCHED;
        }
        if (wr == 0) PG8_BAR;
        E(acc, cur, wr, wc, fr, fq);
        if (!has_next) break;
#pragma unroll
        for (int a = 0; a < 2; ++a)
#pragma unroll
            for (int b = 0; b < 2; ++b)
#pragma unroll
                for (int m = 0; m < 4; ++m)
#pragma unroll
                    for (int n = 0; n < 2; ++n) acc[a][b][m][n] = (f32x4){0.f, 0.f, 0.f, 0.f};
        cur = nxt; cA = nA; cB = nB; ++ui;
        if (wr == 1) PG8_BAR;
    }
    PG8_WAIT_V(0);
    PG8_BAR;
#undef PG8_SA
#undef PG8_SB
#undef PG8_STAGE
#undef PG8_LDA
#undef PG8_LDB
#undef PG8_MMA
#undef PG8_WAIT_V
#undef PG8_WAIT_L
#undef PG8_BAR
#undef PG8_SCHED
}
}

constexpr size_t MiB = 1u << 20;
constexpr size_t WS_CTL = 0, CTL_ZERO_BYTES = 64 * 1024;
constexpr size_t WS_WINT = 1 * MiB, WS_WGLUT = 3 * MiB, WS_WOUTT = 5 * MiB, WS_BINT = 7 * MiB, WS_BOUTT = 13 * MiB, WS_WQN = 15 * MiB, WS_WOT = 19 * MiB,
                 WS_WKVT = 23 * MiB, WS_W1T = 31 * MiB, WS_W2T = 47 * MiB;
constexpr size_t WS_MEMN = 63 * MiB, WS_KV = 65 * MiB, WS_WEFFT = 73 * MiB, WS_VWT = 89 * MiB, WS_HB = 105 * MiB, WS_SSQP = 169 * MiB;
constexpr size_t WS_WS = 171 * MiB, WS_W3 = 187 * MiB, WS_UX = 235 * MiB, WS_S = 331 * MiB, WS_ZGM = 395 * MiB;
constexpr size_t WS_Z2 = 235 * MiB, WS_P = 171 * MiB, WS_AFF = 235 * MiB, WS_ZBV = 235 * MiB, WS_CG = 299 * MiB, WS_ZC = 363 * MiB, WS_END = 491 * MiB;
constexpr int CW_BAR = 4096;
constexpr int RING_BYTES = 131072, XCH_OFF = RING_BYTES, MISC_OFF = RING_BYTES + 8192 + 1024, LDS_BYTES = 147456;
constexpr int NWAVES = 8;

#define RLX_AGENT __ATOMIC_RELAXED, __HIP_MEMORY_SCOPE_AGENT
#define LDS_WAIT() asm volatile("s_waitcnt lgkmcnt(0)" ::: "memory")
#define VM_WAIT() asm volatile("s_waitcnt vmcnt(0)" ::: "memory")

#define XB_TMO      128
#define XB_XCNT(j)  (256  + 64 * (j))
#define XB_XSUB(j)  (1280 + 64 * (j))
#define XB_XGEN(j)  (2304 + 64 * (j))
#define XB_TOP      3328
#define XB_TOPGEN   3392
#define XCD_BAR_WORDS 3456
#define XB_SPIN_CAP (1u << 20)
__device__ __forceinline__ unsigned xb_ld(unsigned* p)              { return __hip_atomic_load(p, __ATOMIC_RELAXED, __HIP_MEMORY_SCOPE_AGENT); }
__device__ __forceinline__ unsigned xb_add(unsigned* p, unsigned v) { return __hip_atomic_fetch_add(p, v, __ATOMIC_RELAXED, __HIP_MEMORY_SCOPE_AGENT); }
__device__ __forceinline__ unsigned xb_xcc_id() { return (unsigned)__builtin_amdgcn_s_getreg((3 << 11) | 20) & 0xFu; }
#define XB_SPIN(cond, bar) do { unsigned _sp = 0; while (cond) { __builtin_amdgcn_s_sleep(1); \
    if ((++_sp & 255u) == 0u) { if (xb_ld(&(bar)[XB_TMO])) break; if (_sp > XB_SPIN_CAP) { atomicAdd(&(bar)[XB_TMO], 1u); break; } } } } while (0)
struct XcdBarrier { unsigned* bar; unsigned x; volatile LAS unsigned* st; };
__device__ __forceinline__ XcdBarrier xcd_barrier_post(unsigned* bar, volatile LAS unsigned* st) {
    XcdBarrier b; b.bar = bar; b.x = xb_xcc_id(); b.st = st;
    if (threadIdx.x == 0) (void)xb_add(&bar[XB_XCNT(b.x)], 1u);
    return b;
}
__device__ __forceinline__ void xcd_barrier_complete(unsigned* bar, unsigned x, unsigned& nloc, unsigned& nx) {
    const unsigned G = gridDim.x * gridDim.y * gridDim.z;
    unsigned sum, cnt, mine, sp = 0u;
    for (;;) {
        sum = 0u; cnt = 0u; mine = 0u;
#pragma unroll
        for (unsigned j = 0; j < 16; ++j) { const unsigned c = xb_ld(&bar[XB_XCNT(j)]); sum += c; cnt += (c > 0u) ? 1u : 0u; mine = (j == x) ? c : mine; }
        if (sum == G) break;
        __builtin_amdgcn_s_sleep(1);
        if ((++sp & 255u) == 0u) { if (xb_ld(&bar[XB_TMO])) break; if (sp > XB_SPIN_CAP) { atomicAdd(&bar[XB_TMO], 1u); break; } }
    }
    nloc = mine > 0u ? mine : 1u; nx = cnt > 0u ? cnt : 1u;
}
__device__ __forceinline__ void xcd_barrier(const XcdBarrier& b) {
    asm volatile("s_waitcnt vmcnt(0)" ::: "memory");
    __syncthreads();
    if (threadIdx.x == 0) {
        unsigned* bar = b.bar;
        __builtin_amdgcn_s_waitcnt(0);
        unsigned nloc = b.st[0], nx = b.st[1];
        if (nloc == 0u) { xcd_barrier_complete(bar, b.x, nloc, nx); b.st[0] = nloc; b.st[1] = nx; }
        const unsigned old = xb_add(&bar[XB_XSUB(b.x)], 1u);
        const unsigned gen = old / nloc;
        if (old + 1u == (gen + 1u) * nloc) {
            __builtin_amdgcn_fence(__ATOMIC_RELEASE, "agent");
            asm volatile("s_waitcnt vmcnt(0)" ::: "memory");
            const unsigned og = xb_add(&bar[XB_TOP], 1u);
            const unsigned tg = og / nx;
            if (og + 1u == (tg + 1u) * nx) xb_add(&bar[XB_TOPGEN], 1u);
            else XB_SPIN(xb_ld(&bar[XB_TOPGEN]) == tg, bar);
            __builtin_amdgcn_fence(__ATOMIC_ACQUIRE, "agent");
            xb_add(&bar[XB_XGEN(b.x)], 1u);
            asm volatile("s_waitcnt vmcnt(0)" ::: "memory");
        } else {
            XB_SPIN(xb_ld(&bar[XB_XGEN(b.x)]) == gen, bar);
            __builtin_amdgcn_fence(__ATOMIC_ACQUIRE, "agent");
            asm volatile("s_waitcnt vmcnt(0)" ::: "memory");
        }
    }
    __syncthreads();
}

__device__ __forceinline__ float wave_sum(float v) {
#pragma unroll
    for (int o = 1; o < 64; o <<= 1) v += __shfl_xor(v, o);
    return v;
}
using pg8::cvt_pk_bf16;
__device__ __forceinline__ void transpose_item(const float* W, int ldw, int k0, int n0, const float* gain, bf16_t* WT, int K, int drow0, LAS float* scr, int lane) {
#pragma unroll 8
    for (int i = 0; i < 32; ++i) { const int kk = 2 * i + (lane >> 5); float v = W[(size_t)(k0 + kk) * ldw + n0 + (lane & 31)]; if (gain) v *= gain[k0 + kk]; scr[kk * 33 + (lane & 31)] = v; }
    LDS_WAIT(); asm volatile("" ::: "memory");
    const int c = lane & 7;
#pragma unroll
    for (int j = 0; j < 4; ++j) { const int n = (lane >> 3) + 8 * j; const LAS float* s = scr + (8 * c) * 33 + n;
        u32x4 o; o.x = cvt_pk_bf16(s[0 * 33], s[1 * 33]); o.y = cvt_pk_bf16(s[2 * 33], s[3 * 33]); o.z = cvt_pk_bf16(s[4 * 33], s[5 * 33]); o.w = cvt_pk_bf16(s[6 * 33], s[7 * 33]);
        *(u32x4*)(WT + (size_t)(drow0 + n) * K + k0 + 8 * c) = o; }
    LDS_WAIT(); asm volatile("" ::: "memory");
}
__device__ __forceinline__ bool transpose_job(int& r, const float* W, int K, int N, const float* gain, bf16_t* WT, int kind, LAS float* scr, int lane) {
    const int nblk = N / 32, items = (K / 64) * nblk;
    if (r >= items) { r -= items; return false; }
    const int kb = r / nblk, nb = r % nblk, n0 = nb * 32; int drow0 = n0;
    if (kind == 1) { if (n0 < 1024) drow0 = 256 * (n0 >> 7) + (n0 & 127); else if (n0 < 2048) drow0 = 2048 + (n0 - 1024); else drow0 = 256 * ((n0 - 2048) >> 7) + 128 + ((n0 - 2048) & 127); }
    transpose_item(W, N, kb * 64, n0, gain, WT, K, drow0, scr, lane); return true;
}

typedef f32x2 cf;
__device__ __forceinline__ cf mkcf(float a, float b) { cf r; r.x = a; r.y = b; return r; }
__device__ __forceinline__ cf cmul(cf a, cf b) { return mkcf(a.x * b.x - a.y * b.y, a.x * b.y + a.y * b.x); }

__device__ __forceinline__ void ssm_tables(LAS unsigned char* lds, int g, int q, const float* lre, const float* lim, const float* logdt, const float* bre, const float* bim,
                                           const float* cre, const float* cim, const float* dd, bf16_t* WS, bf16_t* W3) {
    LAS cf* apow = (LAS cf*)lds; LAS cf* Bb = apow + 2 * 33 * 64; LAS cf* Cc = Bb + 2 * 64 * 16; LAS float* Kt = (LAS float*)(Cc + 2 * 16 * 64);
    const int tid = threadIdx.x;
    if (tid < 128) {
        const int r = tid >> 6, p = tid & 63; const int gi = (r * 64 + g) * 64 + p;
        const float lr = lre[gi], li = lim[gi], dt = expf(logdt[r * 64 + g]); const float x = lr * dt, y = li * dt;
        for (int k = 0; k <= 32; ++k) { const float mag = expf((float)k * x), ang = (float)k * y; apow[(r * 33 + k) * 64 + p] = mkcf(mag * cosf(ang), mag * sinf(ang)); }
        const float sh = sinf(0.5f * y); const cf am1 = mkcf(expm1f(x) * cosf(y) - 2.0f * sh * sh, expf(x) * sinf(y));
        const float den = 1.0f / (lr * lr + li * li); const cf coef = mkcf((am1.x * lr + am1.y * li) * den, (am1.y * lr - am1.x * li) * den);
        for (int h = 0; h < 16; ++h) { const cf b = mkcf(bre[(size_t)gi * 16 + h], bim[(size_t)gi * 16 + h]); Bb[(r * 64 + p) * 16 + h] = cmul(coef, b); }
    }
    for (int j = 0; j < 4; ++j) { const int idx = tid + 512 * j, r = idx >> 10, h = (idx >> 6) & 15, p = idx & 63; const size_t gi = ((size_t)(r * 64 + g) * 16 + h) * 64 + p; Cc[idx] = mkcf(cre[gi], cim[gi]); }
    __syncthreads();
    {
        const int r = tid >> 8, h = (tid >> 4) & 15, hp = tid & 15; float acc[32];
#pragma unroll
        for (int k = 0; k < 32; ++k) acc[k] = 0.f;
        for (int p = 0; p < 64; ++p) { const cf cb = cmul(Cc[(r * 16 + h) * 64 + p], Bb[(r * 64 + p) * 16 + hp]);
#pragma unroll
            for (int k = 0; k < 32; ++k) { const cf ap = apow[(r * 33 + k) * 64 + p]; acc[k] += cb.x * ap.x - cb.y * ap.y; } }
#pragma unroll
        for (int k = 0; k < 32; ++k) Kt[(r * 32 + k) * 256 + h * 16 + hp] = acc[k];
    }
    __syncthreads();
    {
        const int r = q >> 1, im = q & 1;
        for (int j = 0; j < 8; ++j) { const int idx = tid + 512 * j, p = idx >> 6, kc = idx & 63, s = kc >> 1, h0 = (kc & 1) * 8, e = r == 0 ? 31 - s : s;
            const cf ap = apow[(r * 33 + e) * 64 + p]; float v[8];
#pragma unroll
            for (int i = 0; i < 8; ++i) { const cf z = cmul(ap, Bb[(r * 64 + p) * 16 + h0 + i]); v[i] = im ? z.y : z.x; }
            u32x4 o; o.x = cvt_pk_bf16(v[0], v[1]); o.y = cvt_pk_bf16(v[2], v[3]); o.z = cvt_pk_bf16(v[4], v[5]); o.w = cvt_pk_bf16(v[6], v[7]);
            *(u32x4*)(WS + ((size_t)(g * 256 + 64 * q + p) * KS1 + kc * 8)) = o; }
    }
    {
        for (int j = 0; j < 24; ++j) { const int idx = tid + 512 * j, lrow = idx / 96, kc = idx % 96, n = 128 * q + lrow, tau = n >> 4, h = n & 15, k0 = kc * 8; float v[8];
            if (k0 < 512) { const int s = kc >> 1, h0 = (kc & 1) * 8;
#pragma unroll
                for (int i = 0; i < 8; ++i) { const int hp = h0 + i; float t = 0.f; if (s <= tau) t += Kt[(tau - s) * 256 + h * 16 + hp]; if (s >= tau) t += Kt[(32 + s - tau) * 256 + h * 16 + hp];
                    if (s == tau && h == hp) t += dd[g * 16 + h]; v[i] = t; }
            } else { const int r = k0 >= 640 ? 1 : 0, rel = k0 - (r ? 640 : 512), im = rel >> 6, p0 = rel & 63, e = r ? 32 - tau : tau + 1;
#pragma unroll
                for (int i = 0; i < 8; ++i) { const cf z = cmul(Cc[(r * 16 + h) * 64 + p0 + i], apow[(r * 33 + e) * 64 + p0 + i]); v[i] = im ? -z.y : z.x; } }
            u32x4 o; o.x = cvt_pk_bf16(v[0], v[1]); o.y = cvt_pk_bf16(v[2], v[3]); o.z = cvt_pk_bf16(v[4], v[5]); o.w = cvt_pk_bf16(v[6], v[7]);
            *(u32x4*)(W3 + ((size_t)(g * 512 + n) * KS3 + k0)) = o; }
    }
    __syncthreads();
}

struct Args { const float* in[26]; float* out; unsigned char* ws; int ph_lo, ph_hi, li, pad; };
constexpr int N_PHASES = 19;
#ifndef MK_N_LAUNCHES
#define MK_N_LAUNCHES 1
#endif

__global__ void __launch_bounds__(NWAVES * 64, 2) trunk_fwd(Args args) {
    extern __shared__ __attribute__((aligned(16))) unsigned char lds_raw[];
    LAS unsigned char* lds = (LAS unsigned char*)lds_raw;
    volatile LAS unsigned* MISC = (volatile LAS unsigned*)(lds + MISC_OFF);
    const int G = gridDim.x, bx = blockIdx.x, vcu = (G % 8 == 0) ? (bx % 8) * (G / 8) + bx / 8 : bx, NGW = G * NWAVES;
#define PHASE_IDS int tid = threadIdx.x; asm volatile("" : "+v"(tid)); const int lane = tid & 63, wave = __builtin_amdgcn_readfirstlane(tid >> 6), gw = vcu * NWAVES + wave; (void)lane; (void)gw;
    unsigned char* ws = args.ws;
    unsigned* ctl = (unsigned*)(ws + WS_CTL);
    if (threadIdx.x < 64) MISC[threadIdx.x] = 0u;
    __syncthreads();
    XcdBarrier bar; bar.bar = ctl + CW_BAR; bar.x = 0; bar.st = nullptr;
    if (MK_N_LAUNCHES == 1) bar = xcd_barrier_post(ctl + CW_BAR, MISC + 8);
    const int lo = args.ph_lo, hi = args.ph_hi;
#ifndef PH_MASK
#define PH_MASK 0xFFFFFFFFu
#endif
#define IN(k) (((PH_MASK >> (((k) >= 14 && (k) <= 17) ? (k) - 7 : (k))) & 1u) && lo <= (k) && (k) < hi)
#define SEAM(k) do { if (lo <= (k) && (k) + 1 < hi) xcd_barrier(bar); } while (0)

    const float* x = args.in[0]; const float* mem = args.in[1]; const float* norm_mix = args.in[2]; const float* norm_xattn = args.in[3]; const float* norm_mem = args.in[4];
    const float* norm_ffn = args.in[5]; const float* norm_final = args.in[6];
    float* H = args.out;
    bf16_t* WinT = (bf16_t*)(ws + WS_WINT); bf16_t* WgluT = (bf16_t*)(ws + WS_WGLUT); bf16_t* WoutT = (bf16_t*)(ws + WS_WOUTT); bf16_t* BinT = (bf16_t*)(ws + WS_BINT); bf16_t* BoutT = (bf16_t*)(ws + WS_BOUTT);
    bf16_t* WqN = (bf16_t*)(ws + WS_WQN); bf16_t* WoT = (bf16_t*)(ws + WS_WOT); bf16_t* WkvT = (bf16_t*)(ws + WS_WKVT); bf16_t* W1T = (bf16_t*)(ws + WS_W1T); bf16_t* W2T = (bf16_t*)(ws + WS_W2T);
    bf16_t* memn = (bf16_t*)(ws + WS_MEMN); bf16_t* KV = (bf16_t*)(ws + WS_KV); bf16_t* WeffT = (bf16_t*)(ws + WS_WEFFT); bf16_t* VWT = (bf16_t*)(ws + WS_VWT);
    bf16_t* Hb = (bf16_t*)(ws + WS_HB); float* ssqp = (float*)(ws + WS_SSQP);
    bf16_t* WSs = (bf16_t*)(ws + WS_WS); bf16_t* W3 = (bf16_t*)(ws + WS_W3); bf16_t* UX = (bf16_t*)(ws + WS_UX); float* Ssum = (float*)(ws + WS_S); bf16_t* Zgm = (bf16_t*)(ws + WS_ZGM);
    bf16_t* Z2 = (bf16_t*)(ws + WS_Z2); bf16_t* Pm = (bf16_t*)(ws + WS_P); bf16_t* Aff = (bf16_t*)(ws + WS_AFF); bf16_t* Zbv = (bf16_t*)(ws + WS_ZBV); bf16_t* Cg = (bf16_t*)(ws + WS_CG); bf16_t* Zc = (bf16_t*)(ws + WS_ZC);
    constexpr int BIG = 1 << 30;
    constexpr long TS2K = 256L * 2048;

    if (IN(0)) {
        PHASE_IDS
        for (int it = vcu; it < 4 * NG; it += G)
            ssm_tables(lds, it >> 2, it & 3, args.in[8], args.in[9], args.in[10], args.in[11], args.in[12], args.in[13], args.in[14], args.in[15], WSs, W3);
        __syncthreads();
        LAS float* scr = (LAS float*)(lds + wave * 16384);
        constexpr int I_DD = 16 * 32, I_BIN = 16 * 96, I_KV = 16 * 64, I_W1 = 16 * 128, I_W2 = 64 * 32;
        constexpr int NITEMS = 3 * I_DD + I_BIN + I_DD + 2 * I_DD + 2 * I_KV + 2 * I_W1 + 2 * I_W2;
        for (int it = gw; it < NITEMS; it += NGW) {
            int r = it;
            if (transpose_job(r, args.in[7], D, D, norm_mix, WinT, 0, scr, lane)) continue;
            if (transpose_job(r, args.in[16], D, D, nullptr, WgluT, 0, scr, lane)) continue;
            if (transpose_job(r, args.in[17], D, D, nullptr, WoutT, 0, scr, lane)) continue;
            if (transpose_job(r, args.in[18], D, 3 * D, norm_mix + D, BinT, 1, scr, lane)) continue;
            if (transpose_job(r, args.in[20], D, D, nullptr, BoutT, 0, scr, lane)) continue;
            if (transpose_job(r, args.in[23], D, D, nullptr, WoT, 0, scr, lane)) continue;
            if (transpose_job(r, args.in[23] + (size_t)D * D, D, D, nullptr, WoT + (size_t)D * D, 0, scr, lane)) continue;
            if (transpose_job(r, args.in[22], D, 2 * D, norm_mem, WkvT, 0, scr, lane)) continue;
            if (transpose_job(r, args.in[22] + (size_t)D * 2 * D, D, 2 * D, norm_mem + D, WkvT + (size_t)2 * D * D, 0, scr, lane)) continue;
            if (transpose_job(r, args.in[24], D, FF, norm_ffn, W1T, 0, scr, lane)) continue;
            if (transpose_job(r, args.in[24] + (size_t)D * FF, D, FF, norm_ffn + D, W1T + (size_t)FF * D, 0, scr, lane)) continue;
            if (transpose_job(r, args.in[25], FF, D, nullptr, W2T, 0, scr, lane)) continue;
            transpose_job(r, args.in[25] + (size_t)FF * D, FF, D, nullptr, W2T + (size_t)D * FF, 0, scr, lane);
        }
        for (int rw = gw; rw < 2 * D; rw += NGW) { const float gsc = norm_xattn[rw] * 0.0625f; const f32x4* src = (const f32x4*)(args.in[21] + (size_t)rw * D) + lane; u32x2* dst = (u32x2*)(WqN + (size_t)rw * D) + lane;
#pragma unroll
            for (int j = 0; j < 4; ++j) { const f32x4 v = src[64 * j] * gsc; u32x2 o; o.x = cvt_pk_bf16(v[0], v[1]); o.y = cvt_pk_bf16(v[2], v[3]); dst[64 * j] = o; } }
        for (int t = gw; t < T; t += NGW) { const f32x4* src = (const f32x4*)(x + (size_t)t * D) + lane; u32x2* dst = (u32x2*)(Hb + (size_t)t * D) + lane; float s = 0.f;
#pragma unroll
            for (int j = 0; j < 4; ++j) { const f32x4 v = src[64 * j]; s += (v[0] * v[0] + v[1] * v[1]) + (v[2] * v[2] + v[3] * v[3]); u32x2 o; o.x = cvt_pk_bf16(v[0], v[1]); o.y = cvt_pk_bf16(v[2], v[3]); dst[64 * j] = o; }
            s = wave_sum(s); if (lane < 16) ssqp[(size_t)t * 16 + lane] = lane == 0 ? s : 0.f; }
        for (int t = gw; t < MEMT; t += NGW) { const f32x4* src = (const f32x4*)(mem + (size_t)t * D) + lane; u32x2* dst = (u32x2*)(memn + (size_t)t * D) + lane; f32x4 v[4]; float s = 0.f;
#pragma unroll
            for (int j = 0; j < 4; ++j) { v[j] = src[64 * j]; s += (v[j][0] * v[j][0] + v[j][1] * v[j][1]) + (v[j][2] * v[j][2] + v[j][3] * v[j][3]); }
            const float ri = __builtin_amdgcn_rsqf(wave_sum(s) * (1.0f / D) + EPS);
#pragma unroll
            for (int j = 0; j < 4; ++j) { u32x2 o; o.x = cvt_pk_bf16(v[j][0] * ri, v[j][1] * ri); o.y = cvt_pk_bf16(v[j][2] * ri, v[j][3] * ri); dst[64 * j] = o; } }
        SEAM(0);
    }
    if (IN(1)) {
        { pg8::Gemm g{Hb, WinT, D, 2048u, 32u, 128u, 2048u}; pg8::Order<pg8::MapG> S; S.init(T / 256, D / 256, G, bx, pg8::MapG{TS2K, TS2K, BIG, 0, BIG});
          pg8::EpiU E{UX, ssqp}; pg8::gemm_phase(lds, g, S, E); }
        { pg8::Gemm g{memn, WkvT, D, 2048u, 32u, 128u, 2048u}; pg8::Order<pg8::MapG> S; S.init(8, 8, G, bx, pg8::MapG{TS2K, TS2K, 4, 8, 4});
          pg8::EpiBf16Plain E{KV, 2 * D}; pg8::gemm_phase(lds, g, S, E); }
        SEAM(1);
    }
    if (IN(2)) {
        { pg8::Gemm g{UX, WSs, KS1, KS3 * 2u, 32u, 128u, KS1 * 2u}; pg8::Order<pg8::MapG> S; S.init(NG * NCH / 256, 1, G, bx, pg8::MapG{256L * KS3 * 2, 256L * KS1 * 2, 4, 1, BIG});
          pg8::EpiF32Plain E{Ssum, 256}; pg8::gemm_phase(lds, g, S, E); }
        struct MapWeff { __device__ __forceinline__ void map(int pm, int pn, pg8::Unit& u) const { u.pm = pm; u.pn = pn;
            u.aoff = ((long)(pm >> 2) * 256 * 2048 + (pm & 3) * 256) * 2; u.boff = ((long)(pm >> 4) * D * D + (long)pn * 256 * D + (pm & 3) * 256) * 2; } };
        { pg8::Gemm g{KV, WqN, 256, 4096u, 32u, 128u, 2048u}; pg8::Order<MapWeff> S; S.init(32, 4, G, bx, MapWeff{});
          pg8::EpiBf16Plain E{WeffT, D}; pg8::gemm_phase(lds, g, S, E); }
        struct MapVW { __device__ __forceinline__ void map(int pm, int pn, pg8::Unit& u) const { u.pm = pm; u.pn = pn;
            u.aoff = ((long)(pm >> 4) * D * D + (long)(pm & 3) * 256 * D + pn * 256) * 2; u.boff = ((long)(pm >> 2) * 256 * 2048 + 1024 + pn * 256) * 2; } };
        { pg8::Gemm g{WoT, KV, 256, 2048u, 32u, 128u, 4096u}; pg8::Order<MapVW> S; S.init(32, 4, G, bx, MapVW{});
          pg8::EpiBf16Plain E{VWT, D}; pg8::gemm_phase(lds, g, S, E); }
        SEAM(2);
    }
    if (IN(3)) {
        PHASE_IDS
        for (int it = vcu; it < NB * NG; it += G) {
            const int b = it & 3, g = it >> 2;
            if (wave < 2) {
                const int r = wave, p = lane; const int gi = (r * 64 + g) * 64 + p;
                const float lr = args.in[8][gi], li = args.in[9][gi], dt = expf(args.in[10][r * 64 + g]);
                const float mag = expf(32.0f * lr * dt), ang = 32.0f * li * dt; const float ax = mag * cosf(ang), ay = mag * sinf(ang);
                float X = 0.f, Y = 0.f;
                const size_t row0 = (size_t)g * NCH + (size_t)b * NCHB;
                for (int c0 = 0; c0 < NCHB; c0 += 8) {
                    float sx[8], sy[8];
#pragma unroll
                    for (int i = 0; i < 8; ++i) { const int c = r == 0 ? c0 + i : NCHB - 1 - (c0 + i); const float* sp = Ssum + (row0 + c) * 256 + r * 128 + p; sx[i] = sp[0]; sy[i] = sp[64]; }
#pragma unroll
                    for (int i = 0; i < 8; ++i) { const int c = r == 0 ? c0 + i : NCHB - 1 - (c0 + i); bf16_t* up = UX + (row0 + c) * KS3 + KS1 + r * 128 + p;
                        const unsigned w = cvt_pk_bf16(X, Y); up[0] = (bf16_t)(w & 0xffffu); up[64] = (bf16_t)(w >> 16);
                        const float nX = ax * X - ay * Y + sx[i], nY = ax * Y + ay * X + sy[i]; X = nX; Y = nY; }
                }
            }
        }
        SEAM(3);
    }
    if (IN(4)) {
        pg8::Gemm g{UX, W3, KS3, KS3 * 2u, 32u, 128u, KS3 * 2u}; pg8::Order<pg8::MapG> S; S.init(NG * NCH / 256, 2, G, bx, pg8::MapG{256L * KS3 * 2, 256L * KS3 * 2, 4, 2, BIG});
        pg8::EpiGelu E{Zgm}; pg8::gemm_phase(lds, g, S, E);
        SEAM(4);
    }
    if (IN(5)) {
        pg8::Gemm g{Zgm, WgluT, D, 32u, (unsigned)T * 32u, 4u * (unsigned)T * 32u, 2048u}; pg8::Order<pg8::MapG> S; S.init(T / 256, D / 256, G, bx, pg8::MapG{256L * 32, TS2K, BIG, 0, BIG});
        pg8::EpiGlu E{Zgm, Z2}; pg8::gemm_phase(lds, g, S, E);
        SEAM(5);
    }
    if (IN(6)) {
        pg8::Gemm g{Z2, WoutT, D, 2048u, 32u, 128u, 2048u}; pg8::Order<pg8::MapG> S; S.init(T / 256, D / 256, G, bx, pg8::MapG{TS2K, TS2K, BIG, 0, BIG});
        pg8::EpiRes E{Hb, ssqp}; pg8::gemm_phase(lds, g, S, E);
        SEAM(6);
    }
    for (int layer = 0; layer < 2; ++layer) {
        if (layer == 1) {
            if (IN(11)) {
                pg8::Gemm g{Hb, BinT, D, 2048u, 32u, 128u, 2048u}; pg8::Order<pg8::MapG> S; S.init(T / 256, 12, G, bx, pg8::MapG{TS2K, TS2K, BIG, 0, BIG});
                pg8::EpiBCV E{Zbv, Cg, ssqp}; pg8::gemm_phase(lds, g, S, E);
                SEAM(11);
            }
            if (IN(12)) {
                PHASE_IDS
                const float* cw = args.in[19];
                f32x4 w0[4], w1[4], w2[4];
#pragma unroll
                for (int j = 0; j < 4; ++j) { w0[j] = *(const f32x4*)(cw + 16 * lane + 4 * j); w1[j] = *(const f32x4*)(cw + D + 16 * lane + 4 * j); w2[j] = *(const f32x4*)(cw + 2 * D + 16 * lane + 4 * j); }
                for (int blk = gw; blk < T / 16; blk += NGW) {
                    const int t0 = blk * 16; f32x4 pv[4], cv[4], nv[4];
                    if ((t0 & (SEQ - 1)) == 0) {
#pragma unroll
                        for (int j = 0; j < 4; ++j) pv[j] = (f32x4){0.f, 0.f, 0.f, 0.f};
                    } else { const u32x4* zp = (const u32x4*)(Zbv + (size_t)(t0 - 1) * D + 16 * lane); pg8::unpack8(zp[0], pv[0], pv[1]); pg8::unpack8(zp[1], pv[2], pv[3]); }
                    { const u32x4* zp = (const u32x4*)(Zbv + (size_t)t0 * D + 16 * lane); pg8::unpack8(zp[0], cv[0], cv[1]); pg8::unpack8(zp[1], cv[2], cv[3]); }
                    for (int i = 0; i < 16; ++i) { const int t = t0 + i;
                        if ((t & (SEQ - 1)) == SEQ - 1) {
#pragma unroll
                            for (int j = 0; j < 4; ++j) nv[j] = (f32x4){0.f, 0.f, 0.f, 0.f};
                        } else { const u32x4* zp = (const u32x4*)(Zbv + (size_t)(t + 1) * D + 16 * lane); pg8::unpack8(zp[0], nv[0], nv[1]); pg8::unpack8(zp[1], nv[2], nv[3]); }
                        const u32x4* cp = (const u32x4*)(Cg + (size_t)t * D + 16 * lane); f32x4 gc[4]; pg8::unpack8(cp[0], gc[0], gc[1]); pg8::unpack8(cp[1], gc[2], gc[3]);
                        f32x4 o[4];
#pragma unroll
                        for (int j = 0; j < 4; ++j) { o[j] = gc[j] * (w0[j] * pv[j] + w1[j] * cv[j] + w2[j] * nv[j]); pv[j] = cv[j]; cv[j] = nv[j]; }
                        u32x4* op = (u32x4*)(Zc + (size_t)t * D + 16 * lane); op[0] = pg8::pack8(o[0], o[1]); op[1] = pg8::pack8(o[2], o[3]); }
                }
                SEAM(12);
            }
            if (IN(13)) {
                pg8::Gemm g{Zc, BoutT, D, 2048u, 32u, 128u, 2048u}; pg8::Order<pg8::MapG> S; S.init(T / 256, D / 256, G, bx, pg8::MapG{TS2K, TS2K, BIG, 0, BIG});
                pg8::EpiRes E{Hb, ssqp}; pg8::gemm_phase(lds, g, S, E);
                SEAM(13);
            }
        }
        const int pb = layer ? 14 : 7;
        if (IN(pb)) {
            pg8::Gemm g{Hb, WeffT + (size_t)layer * NB * D * D, D, 2048u, 32u, 128u, 2048u}; pg8::Order<pg8::MapG> S; S.init(T / 256, D / 256, G, bx, pg8::MapG{TS2K, TS2K, SEQ / 256, 4, BIG});
            pg8::EpiSoftmax E{Pm, ssqp, (LAS f32x2*)(lds + XCH_OFF)}; pg8::gemm_phase(lds, g, S, E);
            SEAM(pb);
        }
        if (IN(pb + 1)) {
            pg8::Gemm g{Pm, VWT + (size_t)layer * NB * D * D, D, 2048u, 32u, 128u, 2048u}; pg8::Order<pg8::MapG> S; S.init(T / 256, D / 256, G, bx, pg8::MapG{TS2K, TS2K, SEQ / 256, 4, BIG});
            pg8::EpiRes E{Hb, ssqp}; pg8::gemm_phase(lds, g, S, E);
            SEAM(pb + 1);
        }
        if (IN(pb + 2)) {
            pg8::Gemm g{Hb, W1T + (size_t)layer * FF * D, D, 2048u, 32u, 128u, 2048u}; pg8::Order<pg8::MapG> S; S.init(T / 256, FF / 256, G, bx, pg8::MapG{TS2K, TS2K, BIG, 0, BIG});
            pg8::EpiRelu2 E{Aff, ssqp}; pg8::gemm_phase(lds, g, S, E);
            SEAM(pb + 2);
        }
        if (IN(pb + 3)) {
            pg8::Gemm g{Aff, W2T + (size_t)layer * D * FF, FF, 8192u, 32u, 128u, 8192u}; pg8::Order<pg8::MapG> S; S.init(T / 256, D / 256, G, bx, pg8::MapG{256L * 8192, 256L * 8192, BIG, 0, BIG});
            pg8::EpiRes E{Hb, ssqp}; pg8::gemm_phase(lds, g, S, E);
            SEAM(pb + 3);
        }
    }
    if (IN(18)) {
        PHASE_IDS
        f32x4 gn[4];
#pragma unroll
        for (int j = 0; j < 4; ++j) gn[j] = ((const f32x4*)norm_final)[lane + 64 * j];
        for (int t = gw; t < T; t += NGW) { const float ri = pg8::row_rinv(ssqp, t); const u32x2* hp = (const u32x2*)(Hb + (size_t)t * D) + lane; f32x4* op = (f32x4*)(H + (size_t)t * D) + lane;
#pragma unroll
            for (int j = 0; j < 4; ++j) { const u32x2 w = hp[64 * j]; f32x4 v; v[0] = __uint_as_float(w.x << 16); v[1] = __uint_as_float(w.x & 0xffff0000u); v[2] = __uint_as_float(w.y << 16); v[3] = __uint_as_float(w.y & 0xffff0000u);
                op[64 * j] = v * gn[j] * ri; } }
    }
#undef IN
#undef SEAM
}

extern "C" void kernel_launch(void* const* d_in, const int* in_sizes, int n_in, void* d_out, int out_size, void* d_ws, size_t ws_size, hipStream_t stream) {
    static int grid = 0;
    if (grid == 0) {
        if (n_in != 26 || in_sizes[0] != T * D || out_size != T * D || ws_size < WS_END) {
            fprintf(stderr, "kernel_launch: built for 26 inputs, x/out of %d floats, >= %zu bytes of workspace; got n_in %d, in0 %d, out %d, ws %zu; nothing launched\n", T * D, (size_t)WS_END, n_in, n_in > 0 ? in_sizes[0] : -1, out_size, ws_size);
            grid = -1; return; }
        int dev = 0, cus = 0, per_cu = 0;
        if (hipGetDevice(&dev) != hipSuccess || hipDeviceGetAttribute(&cus, hipDeviceAttributeMultiprocessorCount, dev) != hipSuccess) { fprintf(stderr, "kernel_launch: device query failed\n"); grid = -1; return; }
        if (hipFuncSetAttribute((const void*)trunk_fwd, hipFuncAttributeMaxDynamicSharedMemorySize, LDS_BYTES) != hipSuccess) { fprintf(stderr, "kernel_launch: hipFuncSetAttribute failed\n"); grid = -1; return; }
        if (hipOccupancyMaxActiveBlocksPerMultiprocessor(&per_cu, (const void*)trunk_fwd, NWAVES * 64, LDS_BYTES) != hipSuccess || per_cu < 1)
            fprintf(stderr, "kernel_launch: note: occupancy query reports %d workgroups per CU\n", per_cu);
        (void)hipGetLastError();
        grid = cus;
    }
    if (grid < 0) return;
    if (hipMemsetAsync((char*)d_ws + WS_CTL, 0, CTL_ZERO_BYTES, stream) != hipSuccess) { fprintf(stderr, "kernel_launch: hipMemsetAsync failed\n"); return; }
    Args a{};
    for (int i = 0; i < 26; ++i) a.in[i] = (const float*)d_in[i];
    a.out = (float*)d_out; a.ws = (unsigned char*)d_ws;
#if MK_N_LAUNCHES == 1
    a.ph_lo = 0; a.ph_hi = N_PHASES; a.li = 0;
    void* kargs[] = {&a};
    hipError_t e = hipLaunchCooperativeKernel((const void*)trunk_fwd, dim3(grid), dim3(NWAVES * 64), kargs, LDS_BYTES, stream);
    if (e != hipSuccess) { fprintf(stderr, "kernel_launch: cooperative launch failed: %s (grid %d)\n", hipGetErrorString(e), grid); (void)hipGetLastError();
        hipLaunchKernelGGL(trunk_fwd, dim3(grid), dim3(NWAVES * 64), LDS_BYTES, stream, a); }
#else
    for (int ph = 0; ph < N_PHASES; ++ph) { a.ph_lo = ph; a.ph_hi = ph + 1; a.li = ph; hipLaunchKernelGGL(trunk_fwd, dim3(grid), dim3(NWAVES * 64), LDS_BYTES, stream, a); }
#endif
}
```

```cpp
#include <hip/hip_runtime.h>
#include <cstdio>
#include <cstdint>

#define LAS __attribute__((address_space(3)))
#define GAS __attribute__((address_space(1)))
typedef unsigned short bf16_t;
typedef short bf16x8 __attribute__((ext_vector_type(8)));
typedef float f32x4 __attribute__((ext_vector_type(4)));
typedef float f32x2 __attribute__((ext_vector_type(2)));
typedef unsigned u32x4 __attribute__((ext_vector_type(4)));
typedef unsigned u32x2 __attribute__((ext_vector_type(2)));

constexpr int T = 32768, D = 1024, FF = 4096, SEQ = 8192, NB = 4, MEMT = 1024, MEML = 256;
constexpr int NG = 64, CN = 32, NCH = T / CN, NCHB = SEQ / CN, KS1 = CN * 16, KS3 = CN * 16 + 256;
constexpr float EPS = 1e-6f;

namespace pg8 {
constexpr int BM = 256, BK = 64, HALF = 128, HTB = HALF * BK * 2, STAGE_BYTES = 8 * HTB, NXCD = 8, WGM = 8;
__host__ __device__ __forceinline__ int lds_byte(int r, int c) { const int st = (r >> 4) * 2 + (c >> 5), rr = r & 15, cc = c & 31, ob = rr * 64 + cc * 2; return st * 1024 + (ob ^ (((ob >> 9) & 1) << 5)); }
__host__ __device__ __forceinline__ void stage_rc(int b, int& R, int& C) { const int st = b / 1024, sb = b % 1024, swz = sb ^ (((sb >> 9) & 1) << 5); R = (st >> 1) * 16 + swz / 64; C = (st & 1) * 32 + (swz % 64) / 2; }
__host__ __device__ __forceinline__ int perm32(int rho) { const int n = rho >> 4, i = rho & 15; return 8 * (i >> 2) + 4 * n + (i & 3); }

struct Unit { int pm, pn; long aoff, boff; };
struct Gemm { const bf16_t* A; const bf16_t* Bt; int K; unsigned a_rs, a_c16, a_kstep, b_rs; };

template <class Map> struct Order {
    int nM, nN, nwg, G, c; Map mp;
    __device__ __forceinline__ void init(int nM_, int nN_, int G_, int c_, const Map& m) { nM = nM_; nN = nN_; nwg = nM * nN; G = G_; c = c_; mp = m; }
    __device__ __forceinline__ bool next(int i, Unit& u) const {
        const long L = (long)i * G + c; if (L >= nwg) return false;
        int wgid = (int)L; { const int q = nwg / NXCD, r = nwg % NXCD, xcd = wgid % NXCD, off = wgid / NXCD; wgid = (xcd < r ? xcd * (q + 1) : r * (q + 1) + (xcd - r) * q) + off; }
        const int nig = WGM * nN, gid = wgid / nig, fm = gid * WGM, gsz = (nM - fm) < WGM ? (nM - fm) : WGM;
        const int pm = fm + ((wgid % nig) % gsz), pn = (wgid % nig) / gsz;
        mp.map(pm, pn, u); return true;
    }
};
struct MapG { long a_t, b_t; int grp_m, nNb, a_mod;
    __device__ __forceinline__ void map(int pm, int pn, Unit& u) const { u.pm = pm; u.pn = pn; u.aoff = (long)(pm % a_mod) * a_t; u.boff = (long)((pm / grp_m) * nNb + pn) * b_t; } };

__device__ __forceinline__ unsigned cvt_pk_bf16(float lo, float hi) { unsigned r; asm volatile("v_cvt_pk_bf16_f32 %0, %1, %2" : "=v"(r) : "v"(lo), "v"(hi)); return r; }
__device__ __forceinline__ u32x4 pack8(const f32x4 a, const f32x4 b) { u32x4 w; w.x = cvt_pk_bf16(a[0], a[1]); w.y = cvt_pk_bf16(a[2], a[3]); w.z = cvt_pk_bf16(b[0], b[1]); w.w = cvt_pk_bf16(b[2], b[3]); return w; }
__device__ __forceinline__ void unpack8(const u32x4 w, f32x4& a, f32x4& b) {
    a[0] = __uint_as_float(w.x << 16); a[1] = __uint_as_float(w.x & 0xffff0000u); a[2] = __uint_as_float(w.y << 16); a[3] = __uint_as_float(w.y & 0xffff0000u);
    b[0] = __uint_as_float(w.z << 16); b[1] = __uint_as_float(w.z & 0xffff0000u); b[2] = __uint_as_float(w.w << 16); b[3] = __uint_as_float(w.w & 0xffff0000u); }
__device__ __forceinline__ float row_rinv(const float* ssqp, int row) {
    const f32x4* p = (const f32x4*)(ssqp + (size_t)row * 16); const f32x4 a = p[0], b = p[1], c = p[2], d = p[3];
    const f32x4 s = (a + b) + (c + d); return __builtin_amdgcn_rsqf(((s[0] + s[1]) + (s[2] + s[3])) * (1.0f / 1024.0f) + EPS); }

#define EPI_ROWS_BEGIN _Pragma("unroll") for (int ai = 0; ai < 2; ++ai) _Pragma("unroll") for (int m = 0; m < 4; ++m) { const int rt = ai * 128 + wr * 64 + m * 16 + fr; const int row = u.pm * 256 + rt; (void)row;
#define EPI_ROWS_END }
#define EPI_COLS_BEGIN _Pragma("unroll") for (int bj = 0; bj < 2; ++bj) { const int ct = bj * 128 + wc * 32 + 8 * fq; (void)ct;
#define EPI_COLS_END }

struct EpiBf16Plain {
    bf16_t* O; int ldc;
    __device__ __forceinline__ void operator()(f32x4 (&acc)[2][2][4][2], const Unit& u, int wr, int wc, int fr, int fq) const {
        EPI_ROWS_BEGIN bf16_t* rowp = O + (size_t)row * ldc + u.pn * 256;
        EPI_COLS_BEGIN *(u32x4*)(rowp + ct) = pack8(acc[ai][bj][m][0], acc[ai][bj][m][1]); EPI_COLS_END
        EPI_ROWS_END }
};
struct EpiF32Plain {
    float* O; int ldc;
    __device__ __forceinline__ void operator()(f32x4 (&acc)[2][2][4][2], const Unit& u, int wr, int wc, int fr, int fq) const {
        EPI_ROWS_BEGIN float* rowp = O + (size_t)row * ldc + u.pn * 256;
        EPI_COLS_BEGIN *(f32x4*)(rowp + ct) = acc[ai][bj][m][0]; *(f32x4*)(rowp + ct + 4) = acc[ai][bj][m][1]; EPI_COLS_END
        EPI_ROWS_END }
};
struct EpiU {
    bf16_t* UX; const float* ssqp;
    __device__ __forceinline__ void operator()(f32x4 (&acc)[2][2][4][2], const Unit& u, int wr, int wc, int fr, int fq) const {
        EPI_ROWS_BEGIN const float ri = row_rinv(ssqp, row); const int ch = row >> 5, tau = row & 31;
        EPI_COLS_BEGIN const int col = u.pn * 256 + ct, g = col >> 4, h0 = col & 15;
            *(u32x4*)(UX + ((size_t)g * NCH + ch) * KS3 + tau * 16 + h0) = pack8(acc[ai][bj][m][0] * ri, acc[ai][bj][m][1] * ri); EPI_COLS_END
        EPI_ROWS_END }
};
__device__ __forceinline__ float gelu_tanh(float x) {
    const float t = x * (0.7978845608f + 0.0356774081f * x * x);
    return x * __builtin_amdgcn_rcpf(1.0f + __builtin_amdgcn_exp2f(-2.8853900818f * t)); }
__device__ __forceinline__ float sigmoidf_(float x) { return __builtin_amdgcn_rcpf(1.0f + __builtin_amdgcn_exp2f(-1.4426950409f * x)); }
struct EpiGelu {
    bf16_t* O;
    __device__ __forceinline__ void operator()(f32x4 (&acc)[2][2][4][2], const Unit& u, int wr, int wc, int fr, int fq) const {
        EPI_ROWS_BEGIN bf16_t* rowp = O + (size_t)row * 512 + u.pn * 256;
        EPI_COLS_BEGIN f32x4 a = acc[ai][bj][m][0], b = acc[ai][bj][m][1];
#pragma unroll
            for (int e = 0; e < 4; ++e) { a[e] = gelu_tanh(a[e]); b[e] = gelu_tanh(b[e]); }
            *(u32x4*)(rowp + ct) = pack8(a, b); EPI_COLS_END
        EPI_ROWS_END }
};
struct EpiGlu {
    const bf16_t* Zgm; bf16_t* Z2;
    __device__ __forceinline__ void operator()(f32x4 (&acc)[2][2][4][2], const Unit& u, int wr, int wc, int fr, int fq) const {
        EPI_ROWS_BEGIN
        EPI_COLS_BEGIN const int col = u.pn * 256 + ct; const u32x4 zw = *(const u32x4*)(Zgm + ((size_t)(col >> 4) * T + row) * 16 + (col & 15));
            f32x4 za, zb; unpack8(zw, za, zb); f32x4 a = acc[ai][bj][m][0], b = acc[ai][bj][m][1];
#pragma unroll
            for (int e = 0; e < 4; ++e) { a[e] = za[e] * sigmoidf_(a[e]); b[e] = zb[e] * sigmoidf_(b[e]); }
            *(u32x4*)(Z2 + (size_t)row * D + col) = pack8(a, b); EPI_COLS_END
        EPI_ROWS_END }
};
struct EpiRes {
    bf16_t* Hb; float* ssqp;
    __device__ __forceinline__ void operator()(f32x4 (&acc)[2][2][4][2], const Unit& u, int wr, int wc, int fr, int fq) const {
        EPI_ROWS_BEGIN float ss = 0.f;
        EPI_COLS_BEGIN bf16_t* hp = Hb + (size_t)row * D + u.pn * 256 + ct; f32x4 ha, hb; unpack8(*(const u32x4*)hp, ha, hb);
            const f32x4 a = ha + acc[ai][bj][m][0], b = hb + acc[ai][bj][m][1];
            *(u32x4*)hp = pack8(a, b);
            ss += (a[0] * a[0] + a[1] * a[1]) + (a[2] * a[2] + a[3] * a[3]) + (b[0] * b[0] + b[1] * b[1]) + (b[2] * b[2] + b[3] * b[3]); EPI_COLS_END
            ss += __shfl_xor(ss, 16); ss += __shfl_xor(ss, 32);
            if (fq == 0) ssqp[(size_t)row * 16 + u.pn * 4 + wc] = ss;
        EPI_ROWS_END }
};
struct EpiRelu2 {
    bf16_t* O; const float* ssqp;
    __device__ __forceinline__ void operator()(f32x4 (&acc)[2][2][4][2], const Unit& u, int wr, int wc, int fr, int fq) const {
        EPI_ROWS_BEGIN const float ri = row_rinv(ssqp, row); bf16_t* rowp = O + (size_t)row * FF + u.pn * 256;
        EPI_COLS_BEGIN f32x4 a = acc[ai][bj][m][0] * ri, b = acc[ai][bj][m][1] * ri;
#pragma unroll
            for (int e = 0; e < 4; ++e) { a[e] = fmaxf(a[e], 0.f); a[e] *= a[e]; b[e] = fmaxf(b[e], 0.f); b[e] *= b[e]; }
            *(u32x4*)(rowp + ct) = pack8(a, b); EPI_COLS_END
        EPI_ROWS_END }
};
struct EpiBCV {
    bf16_t* Zbv; bf16_t* Cg; const float* ssqp;
    __device__ __forceinline__ void operator()(f32x4 (&acc)[2][2][4][2], const Unit& u, int wr, int wc, int fr, int fq) const {
        if (u.pn < 8) {
            EPI_ROWS_BEGIN const float ri = row_rinv(ssqp, row), r2 = ri * ri;
                *(u32x4*)(Zbv + (size_t)row * D + u.pn * 128 + wc * 32 + 8 * fq) = pack8(acc[ai][0][m][0] * acc[ai][1][m][0] * r2, acc[ai][0][m][1] * acc[ai][1][m][1] * r2);
            EPI_ROWS_END
        } else {
            EPI_ROWS_BEGIN const float ri = row_rinv(ssqp, row); bf16_t* rowp = Cg + (size_t)row * D + (u.pn - 8) * 256;
            EPI_COLS_BEGIN *(u32x4*)(rowp + ct) = pack8(acc[ai][bj][m][0] * ri, acc[ai][bj][m][1] * ri); EPI_COLS_END
            EPI_ROWS_END
        }
    }
};
struct EpiSoftmax {
    bf16_t* P; const float* ssqp; LAS f32x2* xch;
    __device__ __forceinline__ void operator()(f32x4 (&acc)[2][2][4][2], const Unit& u, int wr, int wc, int fr, int fq) const {
        float mw[2][4];
        EPI_ROWS_BEGIN const float ri = row_rinv(ssqp, row) * 1.4426950409f; float mx = -3.0e38f;
        EPI_COLS_BEGIN
#pragma unroll
            for (int n = 0; n < 2; ++n) { acc[ai][bj][m][n] = acc[ai][bj][m][n] * ri; const f32x4 v = acc[ai][bj][m][n]; mx = fmaxf(mx, fmaxf(fmaxf(v[0], v[1]), fmaxf(v[2], v[3]))); } EPI_COLS_END
            mx = fmaxf(mx, __shfl_xor(mx, 16)); mx = fmaxf(mx, __shfl_xor(mx, 32)); float sm = 0.f;
        EPI_COLS_BEGIN
#pragma unroll
            for (int n = 0; n < 2; ++n) { f32x4 v = acc[ai][bj][m][n];
#pragma unroll
                for (int e = 0; e < 4; ++e) { v[e] = __builtin_amdgcn_exp2f(v[e] - mx); sm += v[e]; } acc[ai][bj][m][n] = v; } EPI_COLS_END
            sm += __shfl_xor(sm, 16); sm += __shfl_xor(sm, 32); mw[ai][m] = mx;
            if (fq == 0) xch[rt * 4 + wc] = (f32x2){mx, sm};
        EPI_ROWS_END
        asm volatile("s_waitcnt lgkmcnt(0)" ::: "memory"); __builtin_amdgcn_s_barrier(); asm volatile("" ::: "memory");
        EPI_ROWS_BEGIN const f32x2 p0 = xch[rt * 4 + 0], p1 = xch[rt * 4 + 1], p2 = xch[rt * 4 + 2], p3 = xch[rt * 4 + 3];
            const float M = fmaxf(fmaxf(p0.x, p1.x), fmaxf(p2.x, p3.x));
            const float Ls = (p0.y * __builtin_amdgcn_exp2f(p0.x - M) + p1.y * __builtin_amdgcn_exp2f(p1.x - M)) + (p2.y * __builtin_amdgcn_exp2f(p2.x - M) + p3.y * __builtin_amdgcn_exp2f(p3.x - M));
            const float f = __builtin_amdgcn_exp2f(mw[ai][m] - M) * __builtin_amdgcn_rcpf(Ls); bf16_t* rowp = P + (size_t)row * D + u.pn * 256;
        EPI_COLS_BEGIN *(u32x4*)(rowp + ct) = pack8(acc[ai][bj][m][0] * f, acc[ai][bj][m][1] * f); EPI_COLS_END
        EPI_ROWS_END
        asm volatile("s_waitcnt lgkmcnt(0)" ::: "memory"); __builtin_amdgcn_s_barrier(); asm volatile("" ::: "memory");
    }
};

template <class Epi, class Sched>
__device__ __forceinline__ void gemm_phase(LAS unsigned char* lds, const Gemm g, const Sched& S, const Epi& E) {
    int tid = threadIdx.x; asm volatile("" : "+v"(tid));
    const int wid = __builtin_amdgcn_readfirstlane(tid >> 6), lane = tid & 63, wr = wid >> 2, wc = wid & 3, fr = lane & 15, fq = lane >> 4;
    const int nt = g.K / BK;
    unsigned voffA[2], voffB[2];
#pragma unroll
    for (int i = 0; i < 2; ++i) { int R, C; stage_rc(tid * 16 + i * 8192, R, C); const int Rb = (R & ~31) + perm32(R & 31);
        voffA[i] = (unsigned)R * g.a_rs + (unsigned)(C >> 4) * g.a_c16 + (unsigned)(C & 15) * 2u; voffB[i] = (unsigned)Rb * g.b_rs + (unsigned)C * 2u; }
    const size_t kstepA = (size_t)g.a_kstep, kstepB = (size_t)(BK * 2);
    const size_t hstepA = (size_t)HALF * g.a_rs, hstepB = (size_t)HALF * g.b_rs;
    const unsigned ldsw = (unsigned)wid * 1024u;
    const int aoff = lds_byte(wr * 64 + fr, fq * 8), boff = lds_byte(wc * 32 + fr, fq * 8);
#define PG8_SA(b, h) (((b) * 2 + (h)) * HTB)
#define PG8_SB(b, h) ((4 + (b) * 2 + (h)) * HTB)
#define PG8_STAGE(bufoff, gbase, voff) do { _Pragma("unroll") for (int _i = 0; _i < 2; ++_i) \
        __builtin_amdgcn_global_load_lds((const unsigned*)((const char*)(gbase) + (voff)[_i]), (LAS unsigned*)(lds + (bufoff) + ldsw + _i * 8192), 16, 0, 0); } while (0)
#define PG8_LDA(dst, b, h) do { _Pragma("unroll") for (int m = 0; m < 4; ++m) _Pragma("unroll") for (int k = 0; k < 2; ++k) dst[m][k] = *(const LAS bf16x8*)(lds + PG8_SA(b, h) + aoff + m * 2048 + k * 1024); } while (0)
#define PG8_LDB(dst, b, h) do { _Pragma("unroll") for (int n = 0; n < 2; ++n) _Pragma("unroll") for (int k = 0; k < 2; ++k) dst[n][k] = *(const LAS bf16x8*)(lds + PG8_SB(b, h) + boff + n * 2048 + k * 1024); } while (0)
#define PG8_MMA(ai, bj, At, Bt) do { __builtin_amdgcn_s_setprio(1); _Pragma("unroll") for (int m = 0; m < 4; ++m) _Pragma("unroll") for (int n = 0; n < 2; ++n) _Pragma("unroll") for (int k = 0; k < 2; ++k) \
        acc[ai][bj][m][n] = __builtin_amdgcn_mfma_f32_16x16x32_bf16(Bt[n][k], At[m][k], acc[ai][bj][m][n], 0, 0, 0); __builtin_amdgcn_s_setprio(0); } while (0)
#define PG8_WAIT_V(n) asm volatile("s_waitcnt vmcnt(" #n ")" ::: "memory")
#define PG8_WAIT_L(n) asm volatile("s_waitcnt lgkmcnt(" #n ")" ::: "memory")
#define PG8_BAR __builtin_amdgcn_s_barrier()
#define PG8_SCHED __builtin_amdgcn_sched_barrier(0)
    Unit cur, nxt; int ui = 0;
    if (!S.next(0, cur)) return;
    f32x4 acc[2][2][4][2];
#pragma unroll
    for (int a = 0; a < 2; ++a)
#pragma unroll
        for (int b = 0; b < 2; ++b)
#pragma unroll
            for (int m = 0; m < 4; ++m)
#pragma unroll
                for (int n = 0; n < 2; ++n) acc[a][b][m][n] = (f32x4){0.f, 0.f, 0.f, 0.f};
    bf16x8 At[4][2], B0[2][2], B1[2][2];
    const char* cA = (const char*)g.A + cur.aoff; const char* cB = (const char*)g.Bt + cur.boff;
    PG8_STAGE(PG8_SB(0, 0), cB, voffB); PG8_STAGE(PG8_SB(0, 1), cB + hstepB, voffB); PG8_STAGE(PG8_SA(0, 0), cA, voffA); PG8_STAGE(PG8_SA(0, 1), cA + hstepA, voffA);
    if (wr == 1) PG8_BAR;
    PG8_WAIT_V(2); PG8_BAR;
    PG8_STAGE(PG8_SB(1, 0), cB + kstepB, voffB); PG8_STAGE(PG8_SA(1, 0), cA + kstepA, voffA); PG8_STAGE(PG8_SB(1, 1), cB + hstepB + kstepB, voffB);
    PG8_WAIT_V(6); PG8_BAR;
#pragma nounroll
    for (;;) {
        const bool has_next = S.next(ui + 1, nxt);
        const char* nA = has_next ? (const char*)g.A + nxt.aoff : cA; const char* nB = has_next ? (const char*)g.Bt + nxt.boff : cB;
#pragma nounroll
        for (int t = 0; t < nt; t += 2) {
            const bool last = (t == nt - 2);
            const char* a1 = cA + (size_t)(t + 1) * kstepA;
            const char* a2 = last ? nA : cA + (size_t)(t + 2) * kstepA; const char* b2 = last ? nB : cB + (size_t)(t + 2) * kstepB;
            const char* a3 = a2 + kstepA; const char* b3 = b2 + kstepB;
            PG8_LDB(B0, 0, 0); PG8_LDB(B1, 0, 1); PG8_SCHED; PG8_LDA(At, 0, 0); PG8_STAGE(PG8_SA(1, 1), a1 + hstepA, voffA);
            PG8_WAIT_V(8); PG8_WAIT_L(0); PG8_BAR; PG8_MMA(0, 0, At, B0); PG8_MMA(0, 1, At, B1); PG8_BAR; PG8_SCHED;
            PG8_LDA(At, 0, 1); PG8_STAGE(PG8_SB(0, 0), b2, voffB); PG8_STAGE(PG8_SB(0, 1), b2 + hstepB, voffB); PG8_STAGE(PG8_SA(0, 0), a2, voffA);
            PG8_WAIT_V(8); PG8_WAIT_L(0); PG8_BAR; PG8_MMA(1, 0, At, B0); PG8_MMA(1, 1, At, B1); PG8_BAR; PG8_SCHED;
            PG8_LDB(B0, 1, 0); PG8_LDB(B1, 1, 1); PG8_SCHED; PG8_LDA(At, 1, 0); PG8_STAGE(PG8_SA(0, 1), a2 + hstepA, voffA);
            PG8_WAIT_V(8); PG8_WAIT_L(0); PG8_BAR; PG8_MMA(0, 0, At, B0); PG8_MMA(0, 1, At, B1); PG8_BAR; PG8_SCHED;
            PG8_LDA(At, 1, 1); PG8_STAGE(PG8_SB(1, 0), b3, voffB); PG8_STAGE(PG8_SB(1, 1), b3 + hstepB, voffB); PG8_STAGE(PG8_SA(1, 0), a3, voffA);
            PG8_WAIT_V(8); PG8_WAIT_L(0); PG8_BAR; PG8_MMA(1, 0, At, B0); PG8_MMA(1, 1, At, B1); PG8_BAR; PG8_SCHED;
        }
        if (wr == 0) PG8_BAR;
        E(acc, cur, wr, wc, fr, fq);
        if (!has_next) break;
#pragma unroll
        for (int a = 0; a < 2; ++a)
#pragma unroll
            for (int b = 0; b < 2; ++b)
#pragma unroll
                for (int m = 0; m < 4; ++m)
#pragma unroll
                    for (int n = 0; n < 2; ++n) acc[a][b][m][n] = (f32x4){0.f, 0.f, 0.f, 0.f};
        cur = nxt; cA = nA; cB = nB; ++ui;
        if (wr == 1) PG8_BAR;
    }
    PG8_WAIT_V(0);
    PG8_BAR;
#undef PG8_SA
#undef PG8_SB
#undef PG8_STAGE
#undef PG8_LDA
#undef PG8_LDB
#undef PG8_MMA
#undef PG8_WAIT_V
#undef PG8_WAIT_L
#undef PG8_BAR
#undef PG8_SCHED
}
}

constexpr size_t MiB = 1u << 20;
constexpr size_t WS_CTL = 0, CTL_ZERO_BYTES = 64 * 1024;
constexpr size_t WS_WINT = 1 * MiB, WS_WGLUT = 3 * MiB, WS_WOUTT = 5 * MiB, WS_BINT = 7 * MiB, WS_BOUTT = 13 * MiB, WS_WQN = 15 * MiB, WS_WOT = 19 * MiB,
                 WS_WKVT = 23 * MiB, WS_W1T = 31 * MiB, WS_W2T = 47 * MiB;
constexpr size_t WS_MEMN = 63 * MiB, WS_KV = 65 * MiB, WS_WEFFT = 73 * MiB, WS_VWT = 89 * MiB, WS_HB = 105 * MiB, WS_SSQP = 169 * MiB;
constexpr size_t WS_WS = 171 * MiB, WS_W3 = 187 * MiB, WS_UX = 235 * MiB, WS_S = 331 * MiB, WS_ZGM = 395 * MiB;
constexpr size_t WS_Z2 = 235 * MiB, WS_P = 171 * MiB, WS_AFF = 235 * MiB, WS_ZBV = 235 * MiB, WS_CG = 299 * MiB, WS_ZC = 363 * MiB;
constexpr size_t WS_KTAB = 492 * MiB, WS_APW = 496 * MiB, WS_CCG = 499 * MiB, WS_END = 500 * MiB;
constexpr size_t WS_KB = WS_KV, WS_VB = WS_KV + 4 * MiB;
constexpr int CW_BAR = 4096;
constexpr int RING_BYTES = 131072, XCH_OFF = RING_BYTES, LDS_BYTES = 163840, MISC_OFF = LDS_BYTES - 256;
constexpr int NWAVES = 8;

#define RLX_AGENT __ATOMIC_RELAXED, __HIP_MEMORY_SCOPE_AGENT
#define LDS_WAIT() asm volatile("s_waitcnt lgkmcnt(0)" ::: "memory")
#define VM_WAIT() asm volatile("s_waitcnt vmcnt(0)" ::: "memory")

#define XB_TMO      128
#define XB_XCNT(j)  (256  + 64 * (j))
#define XB_XSUB(j)  (1280 + 64 * (j))
#define XB_XGEN(j)  (2304 + 64 * (j))
#define XB_TOP      3328
#define XB_TOPGEN   3392
#define XCD_BAR_WORDS 3456
#define XB_SPIN_CAP (1u << 20)
__device__ __forceinline__ unsigned xb_ld(unsigned* p)              { return __hip_atomic_load(p, __ATOMIC_RELAXED, __HIP_MEMORY_SCOPE_AGENT); }
__device__ __forceinline__ unsigned xb_add(unsigned* p, unsigned v) { return __hip_atomic_fetch_add(p, v, __ATOMIC_RELAXED, __HIP_MEMORY_SCOPE_AGENT); }
__device__ __forceinline__ unsigned xb_xcc_id() { return (unsigned)__builtin_amdgcn_s_getreg((3 << 11) | 20) & 0xFu; }
#define XB_SPIN(cond, bar) do { unsigned _sp = 0; while (cond) { __builtin_amdgcn_s_sleep(1); \
    if ((++_sp & 255u) == 0u) { if (xb_ld(&(bar)[XB_TMO])) break; if (_sp > XB_SPIN_CAP) { atomicAdd(&(bar)[XB_TMO], 1u); break; } } } } while (0)
struct XcdBarrier { unsigned* bar; unsigned x; volatile LAS unsigned* st; };
__device__ __forceinline__ XcdBarrier xcd_barrier_post(unsigned* bar, volatile LAS unsigned* st) {
    XcdBarrier b; b.bar = bar; b.x = xb_xcc_id(); b.st = st;
    if (threadIdx.x == 0) (void)xb_add(&bar[XB_XCNT(b.x)], 1u);
    return b;
}
__device__ __forceinline__ void xcd_barrier_complete(unsigned* bar, unsigned x, unsigned& nloc, unsigned& nx) {
    const unsigned G = gridDim.x * gridDim.y * gridDim.z;
    unsigned sum, cnt, mine, sp = 0u;
    for (;;) {
        sum = 0u; cnt = 0u; mine = 0u;
#pragma unroll
        for (unsigned j = 0; j < 16; ++j) { const unsigned c = xb_ld(&bar[XB_XCNT(j)]); sum += c; cnt += (c > 0u) ? 1u : 0u; mine = (j == x) ? c : mine; }
        if (sum == G) break;
        __builtin_amdgcn_s_sleep(1);
        if ((++sp & 255u) == 0u) { if (xb_ld(&bar[XB_TMO])) break; if (sp > XB_SPIN_CAP) { atomicAdd(&bar[XB_TMO], 1u); break; } }
    }
    nloc = mine > 0u ? mine : 1u; nx = cnt > 0u ? cnt : 1u;
}
__device__ __forceinline__ void xcd_barrier(const XcdBarrier& b) {
    asm volatile("s_waitcnt vmcnt(0)" ::: "memory");
    __syncthreads();
    if (threadIdx.x == 0) {
        unsigned* bar = b.bar;
        __builtin_amdgcn_s_waitcnt(0);
        unsigned nloc = b.st[0], nx = b.st[1];
        if (nloc == 0u) { xcd_barrier_complete(bar, b.x, nloc, nx); b.st[0] = nloc; b.st[1] = nx; }
        const unsigned old = xb_add(&bar[XB_XSUB(b.x)], 1u);
        const unsigned gen = old / nloc;
        if (old + 1u == (gen + 1u) * nloc) {
            __builtin_amdgcn_fence(__ATOMIC_RELEASE, "agent");
            asm volatile("s_waitcnt vmcnt(0)" ::: "memory");
            const unsigned og = xb_add(&bar[XB_TOP], 1u);
            const unsigned tg = og / nx;
            if (og + 1u == (tg + 1u) * nx) xb_add(&bar[XB_TOPGEN], 1u);
            else XB_SPIN(xb_ld(&bar[XB_TOPGEN]) == tg, bar);
            __builtin_amdgcn_fence(__ATOMIC_ACQUIRE, "agent");
            xb_add(&bar[XB_XGEN(b.x)], 1u);
            asm volatile("s_waitcnt vmcnt(0)" ::: "memory");
        } else {
            XB_SPIN(xb_ld(&bar[XB_XGEN(b.x)]) == gen, bar);
            __builtin_amdgcn_fence(__ATOMIC_ACQUIRE, "agent");
            asm volatile("s_waitcnt vmcnt(0)" ::: "memory");
        }
    }
    __syncthreads();
}

__device__ __forceinline__ float wave_sum(float v) {
#pragma unroll
    for (int o = 1; o < 64; o <<= 1) v += __shfl_xor(v, o);
    return v;
}
using pg8::cvt_pk_bf16;
__device__ __forceinline__ void transpose_item(const float* W, int ldw, int k0, int n0, const float* gain, bf16_t* WT, int K, int drow0, LAS float* scr, int lane) {
    float v[32];
#pragma unroll
    for (int i = 0; i < 32; ++i) v[i] = W[(size_t)(k0 + 2 * i + (lane >> 5)) * ldw + n0 + (lane & 31)];
    if (gain) {
#pragma unroll
        for (int i = 0; i < 32; ++i) v[i] *= gain[k0 + 2 * i + (lane >> 5)]; }
#pragma unroll
    for (int i = 0; i < 32; ++i) scr[(2 * i + (lane >> 5)) * 33 + (lane & 31)] = v[i];
    LDS_WAIT(); asm volatile("" ::: "memory");
    const int c = lane & 7;
#pragma unroll
    for (int j = 0; j < 4; ++j) { const int n = (lane >> 3) + 8 * j; const LAS float* s = scr + (8 * c) * 33 + n;
        u32x4 o; o.x = cvt_pk_bf16(s[0 * 33], s[1 * 33]); o.y = cvt_pk_bf16(s[2 * 33], s[3 * 33]); o.z = cvt_pk_bf16(s[4 * 33], s[5 * 33]); o.w = cvt_pk_bf16(s[6 * 33], s[7 * 33]);
        *(u32x4*)(WT + (size_t)(drow0 + n) * K + k0 + 8 * c) = o; }
    LDS_WAIT(); asm volatile("" ::: "memory");
}
__device__ __forceinline__ bool transpose_job(int& r, const float* W, int K, int N, const float* gain, bf16_t* WT, int kind, LAS float* scr, int lane) {
    const int nblk = N / 32, items = (K / 64) * nblk;
    if (r >= items) { r -= items; return false; }
    const int kb = r / nblk, nb = r % nblk, n0 = nb * 32; int drow0 = n0;
    if (kind == 1) { if (n0 < 1024) drow0 = 256 * (n0 >> 7) + (n0 & 127); else if (n0 < 2048) drow0 = 2048 + (n0 - 1024); else drow0 = 256 * ((n0 - 2048) >> 7) + 128 + ((n0 - 2048) & 127); }
    transpose_item(W, N, kb * 64, n0, gain, WT, K, drow0, scr, lane); return true;
}

typedef f32x2 cf;
__device__ __forceinline__ cf mkcf(float a, float b) { cf r; r.x = a; r.y = b; return r; }
__device__ __forceinline__ cf cmul(cf a, cf b) { return mkcf(a.x * b.x - a.y * b.y, a.x * b.y + a.y * b.x); }

__device__ __forceinline__ void ssm_tables_a(LAS unsigned char* lds, int g, int q, const float* lre, const float* lim, const float* logdt, const float* bre, const float* bim,
                                             const float* cre, const float* cim, bf16_t* WS, float* Ktab, cf* APW, cf* CCG) {
    LAS cf* apow = (LAS cf*)lds; LAS cf* Bb = apow + 2 * 33 * 64; LAS cf* Cc = Bb + 2 * 64 * 16;
    const int tid = threadIdx.x;
    for (int idx = tid; idx < 2 * 33 * 64; idx += 512) { const int r = idx / 2112, k = (idx % 2112) >> 6, p = idx & 63, gi = (r * 64 + g) * 64 + p;
        const float dt = expf(logdt[r * 64 + g]), x = lre[gi] * dt, y = lim[gi] * dt, mag = expf((float)k * x), ang = (float)k * y; apow[idx] = mkcf(mag * cosf(ang), mag * sinf(ang)); }
    for (int j = 0; j < 4; ++j) { const int idx = tid + 512 * j, r = idx >> 10, p = (idx >> 4) & 63, h = idx & 15, gi = (r * 64 + g) * 64 + p;
        const float lr = lre[gi], li = lim[gi], dt = expf(logdt[r * 64 + g]), x = lr * dt, y = li * dt;
        const float sh = sinf(0.5f * y); const cf am1 = mkcf(expm1f(x) * cosf(y) - 2.0f * sh * sh, expf(x) * sinf(y));
        const float den = 1.0f / (lr * lr + li * li); const cf coef = mkcf((am1.x * lr + am1.y * li) * den, (am1.y * lr - am1.x * li) * den);
        Bb[idx] = cmul(coef, mkcf(bre[(size_t)gi * 16 + h], bim[(size_t)gi * 16 + h])); }
    for (int j = 0; j < 4; ++j) { const int idx = tid + 512 * j, r = idx >> 10, h = (idx >> 6) & 15, p = idx & 63; const size_t gi = ((size_t)(r * 64 + g) * 16 + h) * 64 + p; Cc[idx] = mkcf(cre[gi], cim[gi]); }
    __syncthreads();
    {
        const int r = q >> 1, im = q & 1;
        for (int j = 0; j < 8; ++j) { const int idx = tid + 512 * j, p = idx >> 6, kc = idx & 63, s = kc >> 1, h0 = (kc & 1) * 8, e = r == 0 ? 31 - s : s;
            const cf ap = apow[(r * 33 + e) * 64 + p]; float v[8];
#pragma unroll
            for (int i = 0; i < 8; ++i) { const cf z = cmul(ap, Bb[(r * 64 + p) * 16 + h0 + i]); v[i] = im ? z.y : z.x; }
            u32x4 o; o.x = cvt_pk_bf16(v[0], v[1]); o.y = cvt_pk_bf16(v[2], v[3]); o.z = cvt_pk_bf16(v[4], v[5]); o.w = cvt_pk_bf16(v[6], v[7]);
            *(u32x4*)(WS + ((size_t)(g * 256 + 64 * q + p) * KS1 + kc * 8)) = o; }
    }
    {
        const int r = tid >> 8, h = (tid >> 4) & 15, hp = tid & 15; float acc[8];
#pragma unroll
        for (int k = 0; k < 8; ++k) acc[k] = 0.f;
        for (int p = 0; p < 64; ++p) { const cf cb = cmul(Cc[(r * 16 + h) * 64 + p], Bb[(r * 64 + p) * 16 + hp]);
#pragma unroll
            for (int k = 0; k < 8; ++k) { const cf ap = apow[(r * 33 + 8 * q + k) * 64 + p]; acc[k] += cb.x * ap.x - cb.y * ap.y; } }
#pragma unroll
        for (int k = 0; k < 8; ++k) Ktab[((size_t)(g * 2 + r) * 32 + 8 * q + k) * 256 + h * 16 + hp] = acc[k];
    }
    if (q == 0) {
        for (int idx = tid; idx < 2 * 33 * 64; idx += 512) APW[(size_t)g * 2 * 33 * 64 + idx] = apow[idx];
        for (int idx = tid; idx < 2 * 16 * 64; idx += 512) CCG[(size_t)g * 2 * 16 * 64 + idx] = Cc[idx];
    }
    __syncthreads();
}
__device__ __forceinline__ void ssm_tables_b_load(LAS unsigned char* lds, int g, int q, const float* Ktab, const cf* APW, const cf* CCG) {
    LAS f32x4* Kt4 = (LAS f32x4*)lds; LAS cf* AP8 = (LAS cf*)(lds + 65536); LAS cf* Cc = AP8 + 2 * 8 * 64;
    const int tid = threadIdx.x; const f32x4* ks = (const f32x4*)(Ktab + (size_t)g * 2 * 32 * 256);
#pragma unroll
    for (int j = 0; j < 8; ++j) Kt4[tid + 512 * j] = ks[tid + 512 * j];
    for (int idx = tid; idx < 2 * 8 * 64; idx += 512) { const int r = idx >> 9, i = (idx >> 6) & 7, p = idx & 63, tau = 8 * q + i, e = r ? 32 - tau : tau + 1; AP8[idx] = APW[((size_t)(g * 2 + r) * 33 + e) * 64 + p]; }
    for (int idx = tid; idx < 2 * 16 * 64; idx += 512) Cc[idx] = CCG[(size_t)g * 2 * 16 * 64 + idx];
}
__device__ __forceinline__ void ssm_tables_b_write(LAS unsigned char* lds, int g, int q, int ft  , const float* dd, bf16_t* W3) {
    const LAS float* Kt = (const LAS float*)lds; const LAS cf* AP8 = (const LAS cf*)(lds + 65536); const LAS cf* Cc = AP8 + 2 * 8 * 64;
    for (int j = 0; j < 32; ++j) { const int idx = ft + 384 * j, lrow = idx / 96, kc = idx % 96, n = 128 * q + lrow, tau = n >> 4, h = n & 15, k0 = kc * 8; float v[8];
        if (k0 < 512) { const int s = kc >> 1, h0 = (kc & 1) * 8;
#pragma unroll
            for (int i = 0; i < 8; ++i) { const int hp = h0 + i; float t = 0.f; if (s <= tau) t += Kt[(tau - s) * 256 + h * 16 + hp]; if (s >= tau) t += Kt[(32 + s - tau) * 256 + h * 16 + hp];
                if (s == tau && h == hp) t += dd[g * 16 + h]; v[i] = t; }
        } else { const int r = k0 >= 640 ? 1 : 0, rel = k0 - (r ? 640 : 512), im = rel >> 6, p0 = rel & 63;
#pragma unroll
            for (int i = 0; i < 8; ++i) { const cf z = cmul(Cc[(r * 16 + h) * 64 + p0 + i], AP8[(r * 8 + (tau - 8 * q)) * 64 + p0 + i]); v[i] = im ? -z.y : z.x; } }
        u32x4 o; o.x = cvt_pk_bf16(v[0], v[1]); o.y = cvt_pk_bf16(v[2], v[3]); o.z = cvt_pk_bf16(v[4], v[5]); o.w = cvt_pk_bf16(v[6], v[7]);
        *(u32x4*)(W3 + ((size_t)(g * 512 + n) * KS3 + k0)) = o; }
}

struct Args { const float* in[26]; float* out; unsigned char* ws; int ph_lo, ph_hi, li, pad; };
constexpr int N_PHASES = 19;
#ifndef MK_N_LAUNCHES
#define MK_N_LAUNCHES 1
#endif

__global__ void __launch_bounds__(NWAVES * 64, 2) trunk_fwd(Args args) {
    extern __shared__ __attribute__((aligned(16))) unsigned char lds_raw[];
    LAS unsigned char* lds = (LAS unsigned char*)lds_raw;
    volatile LAS unsigned* MISC = (volatile LAS unsigned*)(lds + MISC_OFF);
    const int G = gridDim.x, bx = blockIdx.x, vcu = (G % 8 == 0) ? (bx % 8) * (G / 8) + bx / 8 : bx, NGW = G * NWAVES;
#define PHASE_IDS int tid = threadIdx.x; asm volatile("" : "+v"(tid)); const int lane = tid & 63, wave = __builtin_amdgcn_readfirstlane(tid >> 6), gw = vcu * NWAVES + wave; (void)lane; (void)gw;
    unsigned char* ws = args.ws;
    unsigned* ctl = (unsigned*)(ws + WS_CTL);
    if (threadIdx.x < 64) MISC[threadIdx.x] = 0u;
    __syncthreads();
    XcdBarrier bar; bar.bar = ctl + CW_BAR; bar.x = 0; bar.st = nullptr;
    if (MK_N_LAUNCHES == 1) bar = xcd_barrier_post(ctl + CW_BAR, MISC + 8);
    const int lo = args.ph_lo, hi = args.ph_hi;
#ifndef PH_MASK
#define PH_MASK 0xFFFFFFFFu
#endif
#define IN(k) (((PH_MASK >> (((k) >= 14 && (k) <= 17) ? (k) - 7 : (k))) & 1u) && lo <= (k) && (k) < hi)
#ifndef TPROBE
#define TPROBE -1
#endif
    unsigned long long tp0 = 0, tp1 = 0;
    if (TPROBE == 0) tp0 = __builtin_amdgcn_s_memrealtime();
#define SEAM(k) do { if (lo <= (k) && (k) + 1 < hi) xcd_barrier(bar); if (TPROBE >= 0) { if ((k) == TPROBE - 1) tp0 = __builtin_amdgcn_s_memrealtime(); if ((k) == TPROBE) tp1 = __builtin_amdgcn_s_memrealtime(); } } while (0)

    const float* x = args.in[0]; const float* mem = args.in[1]; const float* norm_mix = args.in[2]; const float* norm_xattn = args.in[3]; const float* norm_mem = args.in[4];
    const float* norm_ffn = args.in[5]; const float* norm_final = args.in[6];
    float* H = args.out;
    bf16_t* WinT = (bf16_t*)(ws + WS_WINT); bf16_t* WgluT = (bf16_t*)(ws + WS_WGLUT); bf16_t* WoutT = (bf16_t*)(ws + WS_WOUTT); bf16_t* BinT = (bf16_t*)(ws + WS_BINT); bf16_t* BoutT = (bf16_t*)(ws + WS_BOUTT);
    bf16_t* WqN = (bf16_t*)(ws + WS_WQN); bf16_t* WoT = (bf16_t*)(ws + WS_WOT); bf16_t* WkvT = (bf16_t*)(ws + WS_WKVT); bf16_t* W1T = (bf16_t*)(ws + WS_W1T); bf16_t* W2T = (bf16_t*)(ws + WS_W2T);
    bf16_t* memn = (bf16_t*)(ws + WS_MEMN); bf16_t* WeffT = (bf16_t*)(ws + WS_WEFFT); bf16_t* VWT = (bf16_t*)(ws + WS_VWT);
    bf16_t* Hb = (bf16_t*)(ws + WS_HB); float* ssqp = (float*)(ws + WS_SSQP);
    bf16_t* WSs = (bf16_t*)(ws + WS_WS); bf16_t* W3 = (bf16_t*)(ws + WS_W3); bf16_t* UX = (bf16_t*)(ws + WS_UX); float* Ssum = (float*)(ws + WS_S); bf16_t* Zgm = (bf16_t*)(ws + WS_ZGM);
    bf16_t* Z2 = (bf16_t*)(ws + WS_Z2); bf16_t* Pm = (bf16_t*)(ws + WS_P); bf16_t* Aff = (bf16_t*)(ws + WS_AFF); bf16_t* Zbv = (bf16_t*)(ws + WS_ZBV); bf16_t* Cg = (bf16_t*)(ws + WS_CG); bf16_t* Zc = (bf16_t*)(ws + WS_ZC);
    constexpr int BIG = 1 << 30;
    constexpr long TS2K = 256L * 2048;

    float* Ktab = (float*)(ws + WS_KTAB); cf* APW = (cf*)(ws + WS_APW); cf* CCG = (cf*)(ws + WS_CCG); bf16_t* Kb = (bf16_t*)(ws + WS_KB);
    if (IN(0)) {
        PHASE_IDS
        for (int it = vcu; it < 4 * NG; it += G)
            ssm_tables_a(lds, it >> 2, it & 3, args.in[8], args.in[9], args.in[10], args.in[11], args.in[12], args.in[13], args.in[14], WSs, Ktab, APW, CCG);
        for (int t4 = gw * 4; t4 < T; t4 += NGW * 4) { f32x4 v[4][4];
#pragma unroll
            for (int i = 0; i < 4; ++i) { const f32x4* src = (const f32x4*)(x + (size_t)(t4 + i) * D) + lane;
#pragma unroll
                for (int j = 0; j < 4; ++j) v[i][j] = src[64 * j]; }
#pragma unroll
            for (int i = 0; i < 4; ++i) { u32x2* dst = (u32x2*)(Hb + (size_t)(t4 + i) * D) + lane; float s = 0.f;
#pragma unroll
                for (int j = 0; j < 4; ++j) { const f32x4 w = v[i][j]; s += (w[0] * w[0] + w[1] * w[1]) + (w[2] * w[2] + w[3] * w[3]); u32x2 o; o.x = cvt_pk_bf16(w[0], w[1]); o.y = cvt_pk_bf16(w[2], w[3]); dst[64 * j] = o; }
                s = wave_sum(s); if (lane < 16) ssqp[(size_t)(t4 + i) * 16 + lane] = lane == 0 ? s : 0.f; } }
        for (int t = gw; t < MEMT; t += NGW) { const f32x4* src = (const f32x4*)(mem + (size_t)t * D) + lane; u32x2* dst = (u32x2*)(memn + (size_t)t * D) + lane; f32x4 v[4]; float s = 0.f;
#pragma unroll
            for (int j = 0; j < 4; ++j) { v[j] = src[64 * j]; s += (v[j][0] * v[j][0] + v[j][1] * v[j][1]) + (v[j][2] * v[j][2] + v[j][3] * v[j][3]); }
            const float ri = __builtin_amdgcn_rsqf(wave_sum(s) * (1.0f / D) + EPS);
#pragma unroll
            for (int j = 0; j < 4; ++j) { u32x2 o; o.x = cvt_pk_bf16(v[j][0] * ri, v[j][1] * ri); o.y = cvt_pk_bf16(v[j][2] * ri, v[j][3] * ri); dst[64 * j] = o; } }
        for (int rw = gw; rw < 2 * D; rw += NGW) { const float gsc = norm_xattn[rw] * 0.0625f; const f32x4* src = (const f32x4*)(args.in[21] + (size_t)rw * D) + lane; u32x2* dst = (u32x2*)(WqN + (size_t)rw * D) + lane;
#pragma unroll
            for (int j = 0; j < 4; ++j) { const f32x4 v = src[64 * j] * gsc; u32x2 o; o.x = cvt_pk_bf16(v[0], v[1]); o.y = cvt_pk_bf16(v[2], v[3]); dst[64 * j] = o; } }
        LAS float* scr = (LAS float*)(lds + wave * 16384);
        constexpr int I_DD = 16 * 32, I_KV = 16 * 64;
        for (int it = gw; it < 3 * I_DD + 2 * I_KV; it += NGW) {
            int r = it;
            if (transpose_job(r, args.in[7], D, D, norm_mix, WinT, 0, scr, lane)) continue;
            if (transpose_job(r, args.in[22], D, 2 * D, norm_mem, WkvT, 0, scr, lane)) continue;
            if (transpose_job(r, args.in[22] + (size_t)D * 2 * D, D, 2 * D, norm_mem + D, WkvT + (size_t)2 * D * D, 0, scr, lane)) continue;
            if (transpose_job(r, args.in[23], D, D, nullptr, WoT, 0, scr, lane)) continue;
            transpose_job(r, args.in[23] + (size_t)D * D, D, D, nullptr, WoT + (size_t)D * D, 0, scr, lane);
        }
        SEAM(0);
    }
    if (IN(1)) {
        { pg8::Gemm g{Hb, WinT, D, 2048u, 32u, 128u, 2048u}; pg8::Order<pg8::MapG> S; S.init(T / 256, D / 256, G, bx, pg8::MapG{TS2K, TS2K, BIG, 0, BIG});
          pg8::EpiU E{UX, ssqp}; pg8::gemm_phase(lds, g, S, E); }
        struct EpiKV { bf16_t* Kb;
            __device__ __forceinline__ void operator()(f32x4 (&acc)[2][2][4][2], const pg8::Unit& u, int wr, int wc, int fr, int fq) const {
                EPI_ROWS_BEGIN bf16_t* rowp = Kb + (size_t)(u.pn >> 2) * (2 * MEMT * D) + (size_t)row * D + (u.pn & 3) * 256;
                EPI_COLS_BEGIN *(u32x4*)(rowp + ct) = pg8::pack8(acc[ai][bj][m][0], acc[ai][bj][m][1]); EPI_COLS_END
                EPI_ROWS_END } };
        { pg8::Gemm g{memn, WkvT, D, 2048u, 32u, 128u, 2048u}; pg8::Order<pg8::MapG> S; S.init(8, 8, G, bx, pg8::MapG{TS2K, TS2K, 4, 8, 4});
          EpiKV E{Kb}; pg8::gemm_phase(lds, g, S, E); }
        SEAM(1);
    }
    if (IN(2)) {
        { pg8::Gemm g{UX, WSs, KS1, KS3 * 2u, 32u, 128u, KS1 * 2u}; pg8::Order<pg8::MapG> S; S.init(NG * NCH / 256, 1, G, bx, pg8::MapG{256L * KS3 * 2, 256L * KS1 * 2, 4, 1, BIG});
          pg8::EpiF32Plain E{Ssum, 256}; pg8::gemm_phase(lds, g, S, E); }
        struct MapFold { __device__ __forceinline__ void map(int pm, int pn, pg8::Unit& u) const { u.pm = pm; u.pn = pn;
            if (pm < 32) { u.aoff = (long)WS_KB + ((long)(pm >> 2) * 256 * D + (pm & 3) * 256) * 2; u.boff = (long)WS_WQN + ((long)(pm >> 4) * D * D + (long)pn * 256 * D + (pm & 3) * 256) * 2; }
            else { const int pv = pm - 32; u.aoff = (long)WS_WOT + ((long)(pv >> 4) * D * D + (long)(pv & 3) * 256 * D + pn * 256) * 2; u.boff = (long)WS_VB + ((long)(pv >> 2) * 256 * D + pn * 256) * 2; } } };
        { pg8::Gemm g{(const bf16_t*)ws, (const bf16_t*)ws, 256, 2048u, 32u, 128u, 2048u}; pg8::Order<MapFold> S; S.init(64, 4, G, bx, MapFold{});
          pg8::EpiBf16Plain E{WeffT, D}; pg8::gemm_phase(lds, g, S, E); }
        SEAM(2);
    }
    if (IN(3)) {
        PHASE_IDS
        const int g = vcu >> 2, q = vcu & 3, b = vcu & 3;
        ssm_tables_b_load(lds, g, q, Ktab, APW, CCG);
        __syncthreads();
        if (wave < 2) {
            const int r = wave, p = lane; const int gi = (r * 64 + g) * 64 + p;
            const float lr = args.in[8][gi], li = args.in[9][gi], dt = expf(args.in[10][r * 64 + g]);
            const float mag = expf(32.0f * lr * dt), ang = 32.0f * li * dt; const float ax = mag * cosf(ang), ay = mag * sinf(ang);
            float X = 0.f, Y = 0.f;
            const size_t row0 = (size_t)g * NCH + (size_t)b * NCHB;
            for (int c0 = 0; c0 < NCHB; c0 += 8) {
                float sx[8], sy[8];
#pragma unroll
                for (int i = 0; i < 8; ++i) { const int c = r == 0 ? c0 + i : NCHB - 1 - (c0 + i); const float* sp = Ssum + (row0 + c) * 256 + r * 128 + p; sx[i] = sp[0]; sy[i] = sp[64]; }
#pragma unroll
                for (int i = 0; i < 8; ++i) { const int c = r == 0 ? c0 + i : NCHB - 1 - (c0 + i); bf16_t* up = UX + (row0 + c) * KS3 + KS1 + r * 128 + p;
                    const unsigned w = cvt_pk_bf16(X, Y); up[0] = (bf16_t)(w & 0xffffu); up[64] = (bf16_t)(w >> 16);
                    const float nX = ax * X - ay * Y + sx[i], nY = ax * Y + ay * X + sy[i]; X = nX; Y = nY; }
            }
        } else {
            ssm_tables_b_write(lds, g, q, tid - 128, args.in[15], W3);
            LAS float* scr = (LAS float*)(lds + 90112 + (wave - 2) * 8448);
            constexpr int I_DD = 16 * 32, I_BIN = 16 * 96, I_W1 = 16 * 128, I_W2 = 64 * 32;
            for (int it = vcu * 6 + (wave - 2); it < 3 * I_DD + I_BIN + 2 * I_W1 + 2 * I_W2; it += G * 6) {
                int r = it;
                if (transpose_job(r, args.in[16], D, D, nullptr, WgluT, 0, scr, lane)) continue;
                if (transpose_job(r, args.in[17], D, D, nullptr, WoutT, 0, scr, lane)) continue;
                if (transpose_job(r, args.in[24], D, FF, norm_ffn, W1T, 0, scr, lane)) continue;
                if (transpose_job(r, args.in[25], FF, D, nullptr, W2T, 0, scr, lane)) continue;
                if (transpose_job(r, args.in[18], D, 3 * D, norm_mix + D, BinT, 1, scr, lane)) continue;
                if (transpose_job(r, args.in[20], D, D, nullptr, BoutT, 0, scr, lane)) continue;
                if (transpose_job(r, args.in[24] + (size_t)D * FF, D, FF, norm_ffn + D, W1T + (size_t)FF * D, 0, scr, lane)) continue;
                transpose_job(r, args.in[25] + (size_t)FF * D, FF, D, nullptr, W2T + (size_t)D * FF, 0, scr, lane);
            }
        }
        SEAM(3);
    }
    if (IN(4)) {
        pg8::Gemm g{UX, W3, KS3, KS3 * 2u, 32u, 128u, KS3 * 2u}; pg8::Order<pg8::MapG> S; S.init(NG * NCH / 256, 2, G, bx, pg8::MapG{256L * KS3 * 2, 256L * KS3 * 2, 4, 2, BIG});
        pg8::EpiGelu E{Zgm}; pg8::gemm_phase(lds, g, S, E);
        SEAM(4);
    }
    if (IN(5)) {
        pg8::Gemm g{Zgm, WgluT, D, 32u, (unsigned)T * 32u, 4u * (unsigned)T * 32u, 2048u}; pg8::Order<pg8::MapG> S; S.init(T / 256, D / 256, G, bx, pg8::MapG{256L * 32, TS2K, BIG, 0, BIG});
        pg8::EpiGlu E{Zgm, Z2}; pg8::gemm_phase(lds, g, S, E);
        SEAM(5);
    }
    if (IN(6)) {
        pg8::Gemm g{Z2, WoutT, D, 2048u, 32u, 128u, 2048u}; pg8::Order<pg8::MapG> S; S.init(T / 256, D / 256, G, bx, pg8::MapG{TS2K, TS2K, BIG, 0, BIG});
        pg8::EpiRes E{Hb, ssqp}; pg8::gemm_phase(lds, g, S, E);
        SEAM(6);
    }
    for (int layer = 0; layer < 2; ++layer) {
        if (layer == 1) {
            if (IN(11)) {
                pg8::Gemm g{Hb, BinT, D, 2048u, 32u, 128u, 2048u}; pg8::Order<pg8::MapG> S; S.init(T / 256, 12, G, bx, pg8::MapG{TS2K, TS2K, BIG, 0, BIG});
                pg8::EpiBCV E{Zbv, Cg, ssqp}; pg8::gemm_phase(lds, g, S, E);
                SEAM(11);
            }
            if (IN(12)) {
                PHASE_IDS
                const float* cw = args.in[19];
                f32x4 w0[4], w1[4], w2[4];
#pragma unroll
                for (int j = 0; j < 4; ++j) { w0[j] = *(const f32x4*)(cw + 16 * lane + 4 * j); w1[j] = *(const f32x4*)(cw + D + 16 * lane + 4 * j); w2[j] = *(const f32x4*)(cw + 2 * D + 16 * lane + 4 * j); }
                for (int blk = gw; blk < T / 16; blk += NGW) {
                    const int t0 = blk * 16; f32x4 pv[4], cv[4], nv[4];
                    if ((t0 & (SEQ - 1)) == 0) {
#pragma unroll
                        for (int j = 0; j < 4; ++j) pv[j] = (f32x4){0.f, 0.f, 0.f, 0.f};
                    } else { const u32x4* zp = (const u32x4*)(Zbv + (size_t)(t0 - 1) * D + 16 * lane); pg8::unpack8(zp[0], pv[0], pv[1]); pg8::unpack8(zp[1], pv[2], pv[3]); }
                    { const u32x4* zp = (const u32x4*)(Zbv + (size_t)t0 * D + 16 * lane); pg8::unpack8(zp[0], cv[0], cv[1]); pg8::unpack8(zp[1], cv[2], cv[3]); }
                    for (int i = 0; i < 16; ++i) { const int t = t0 + i;
                        if ((t & (SEQ - 1)) == SEQ - 1) {
#pragma unroll
                            for (int j = 0; j < 4; ++j) nv[j] = (f32x4){0.f, 0.f, 0.f, 0.f};
                        } else { const u32x4* zp = (const u32x4*)(Zbv + (size_t)(t + 1) * D + 16 * lane); pg8::unpack8(zp[0], nv[0], nv[1]); pg8::unpack8(zp[1], nv[2], nv[3]); }
                        const u32x4* cp = (const u32x4*)(Cg + (size_t)t * D + 16 * lane); f32x4 gc[4]; pg8::unpack8(cp[0], gc[0], gc[1]); pg8::unpack8(cp[1], gc[2], gc[3]);
                        f32x4 o[4];
#pragma unroll
                        for (int j = 0; j < 4; ++j) { o[j] = gc[j] * (w0[j] * pv[j] + w1[j] * cv[j] + w2[j] * nv[j]); pv[j] = cv[j]; cv[j] = nv[j]; }
                        u32x4* op = (u32x4*)(Zc + (size_t)t * D + 16 * lane); op[0] = pg8::pack8(o[0], o[1]); op[1] = pg8::pack8(o[2], o[3]); }
                }
                SEAM(12);
            }
            if (IN(13)) {
                pg8::Gemm g{Zc, BoutT, D, 2048u, 32u, 128u, 2048u}; pg8::Order<pg8::MapG> S; S.init(T / 256, D / 256, G, bx, pg8::MapG{TS2K, TS2K, BIG, 0, BIG});
                pg8::EpiRes E{Hb, ssqp}; pg8::gemm_phase(lds, g, S, E);
                SEAM(13);
            }
        }
        const int pb = layer ? 14 : 7;
        if (IN(pb)) {
            pg8::Gemm g{Hb, WeffT + (size_t)layer * NB * D * D, D, 2048u, 32u, 128u, 2048u}; pg8::Order<pg8::MapG> S; S.init(T / 256, D / 256, G, bx, pg8::MapG{TS2K, TS2K, SEQ / 256, 4, BIG});
            pg8::EpiSoftmax E{Pm, ssqp, (LAS f32x2*)(lds + XCH_OFF)}; pg8::gemm_phase(lds, g, S, E);
            SEAM(pb);
        }
        if (IN(pb + 1)) {
            pg8::Gemm g{Pm, VWT + (size_t)layer * NB * D * D, D, 2048u, 32u, 128u, 2048u}; pg8::Order<pg8::MapG> S; S.init(T / 256, D / 256, G, bx, pg8::MapG{TS2K, TS2K, SEQ / 256, 4, BIG});
            pg8::EpiRes E{Hb, ssqp}; pg8::gemm_phase(lds, g, S, E);
            SEAM(pb + 1);
        }
        if (IN(pb + 2)) {
            pg8::Gemm g{Hb, W1T + (size_t)layer * FF * D, D, 2048u, 32u, 128u, 2048u}; pg8::Order<pg8::MapG> S; S.init(T / 256, FF / 256, G, bx, pg8::MapG{TS2K, TS2K, BIG, 0, BIG});
            pg8::EpiRelu2 E{Aff, ssqp}; pg8::gemm_phase(lds, g, S, E);
            SEAM(pb + 2);
        }
        if (IN(pb + 3)) {
            pg8::Gemm g{Aff, W2T + (size_t)layer * D * FF, FF, 8192u, 32u, 128u, 8192u}; pg8::Order<pg8::MapG> S; S.init(T / 256, D / 256, G, bx, pg8::MapG{256L * 8192, 256L * 8192, BIG, 0, BIG});
            pg8::EpiRes E{Hb, ssqp}; pg8::gemm_phase(lds, g, S, E);
            SEAM(pb + 3);
        }
    }
    if (IN(18)) {
        PHASE_IDS
        f32x4 gn[4];
#pragma unroll
        for (int j = 0; j < 4; ++j) gn[j] = ((const f32x4*)norm_final)[lane + 64 * j];
        for (int t = gw; t < T; t += NGW) { const float ri = pg8::row_rinv(ssqp, t); const u32x2* hp = (const u32x2*)(Hb + (size_t)t * D) + lane; f32x4* op = (f32x4*)(H + (size_t)t * D) + lane;
#pragma unroll
            for (int j = 0; j < 4; ++j) { const u32x2 w = hp[64 * j]; f32x4 v; v[0] = __uint_as_float(w.x << 16); v[1] = __uint_as_float(w.x & 0xffff0000u); v[2] = __uint_as_float(w.y << 16); v[3] = __uint_as_float(w.y & 0xffff0000u);
                op[64 * j] = v * gn[j] * ri; } }
    }
    if (TPROBE >= 0) { if (TPROBE == 18) tp1 = __builtin_amdgcn_s_memrealtime();
        if (threadIdx.x == 0) { const unsigned long long target = __builtin_amdgcn_s_memrealtime() + 4ull * (tp1 - tp0); while (__builtin_amdgcn_s_memrealtime() < target) __builtin_amdgcn_s_sleep(20); } }
#undef IN
#undef SEAM
}

extern "C" void kernel_launch(void* const* d_in, const int* in_sizes, int n_in, void* d_out, int out_size, void* d_ws, size_t ws_size, hipStream_t stream) {
    static int grid = 0;
    if (grid == 0) {
        if (n_in != 26 || in_sizes[0] != T * D || out_size != T * D || ws_size < WS_END) {
            fprintf(stderr, "kernel_launch: built for 26 inputs, x/out of %d floats, >= %zu bytes of workspace; got n_in %d, in0 %d, out %d, ws %zu; nothing launched\n", T * D, (size_t)WS_END, n_in, n_in > 0 ? in_sizes[0] : -1, out_size, ws_size);
            grid = -1; return; }
        int dev = 0, cus = 0, per_cu = 0;
        if (hipGetDevice(&dev) != hipSuccess || hipDeviceGetAttribute(&cus, hipDeviceAttributeMultiprocessorCount, dev) != hipSuccess) { fprintf(stderr, "kernel_launch: device query failed\n"); grid = -1; return; }
        if (hipFuncSetAttribute((const void*)trunk_fwd, hipFuncAttributeMaxDynamicSharedMemorySize, LDS_BYTES) != hipSuccess) { fprintf(stderr, "kernel_launch: hipFuncSetAttribute failed\n"); grid = -1; return; }
        if (hipOccupancyMaxActiveBlocksPerMultiprocessor(&per_cu, (const void*)trunk_fwd, NWAVES * 64, LDS_BYTES) != hipSuccess || per_cu < 1)
            fprintf(stderr, "kernel_launch: note: occupancy query reports %d workgroups per CU\n", per_cu);
        (void)hipGetLastError();
        if (cus < 256) { fprintf(stderr, "kernel_launch: built for a 256-CU device (got %d CUs); nothing launched\n", cus); grid = -1; return; }
        grid = 256;
    }
    if (grid < 0) return;
    if (hipMemsetAsync((char*)d_ws + WS_CTL, 0, CTL_ZERO_BYTES, stream) != hipSuccess) { fprintf(stderr, "kernel_launch: hipMemsetAsync failed\n"); return; }
    Args a{};
    for (int i = 0; i < 26; ++i) a.in[i] = (const float*)d_in[i];
    a.out = (float*)d_out; a.ws = (unsigned char*)d_ws;
#if MK_N_LAUNCHES == 1
    a.ph_lo = 0; a.ph_hi = N_PHASES; a.li = 0;
    void* kargs[] = {&a};
    hipError_t e = hipLaunchCooperativeKernel((const void*)trunk_fwd, dim3(grid), dim3(NWAVES * 64), kargs, LDS_BYTES, stream);
    if (e != hipSuccess) { fprintf(stderr, "kernel_launch: cooperative launch failed: %s (grid %d)\n", hipGetErrorString(e), grid); (void)hipGetLastError();
        hipLaunchKernelGGL(trunk_fwd, dim3(grid), dim3(NWAVES * 64), LDS_BYTES, stream, a); }
#else
    for (int ph = 0; ph < N_PHASES; ++ph) { a.ph_lo = ph; a.ph_hi = ph + 1; a.li = ph; hipLaunchKernelGGL(trunk_fwd, dim3(grid), dim3(NWAVES * 64), LDS_BYTES, stream, a); }
#endif
}
```

```cpp
#include <hip/hip_runtime.h>
#include <cstdio>
#include <cstdint>

#define LAS __attribute__((address_space(3)))
#define GAS __attribute__((address_space(1)))
typedef unsigned short bf16_t;
typedef short bf16x8 __attribute__((ext_vector_type(8)));
typedef float f32x4 __attribute__((ext_vector_type(4)));
typedef float f32x2 __attribute__((ext_vector_type(2)));
typedef unsigned u32x4 __attribute__((ext_vector_type(4)));
typedef unsigned u32x2 __attribute__((ext_vector_type(2)));

constexpr int T = 32768, D = 1024, FF = 4096, SEQ = 8192, NB = 4, MEMT = 1024, MEML = 256;
constexpr int NG = 64, CN = 32, NCH = T / CN, NCHB = SEQ / CN, KS1 = CN * 16, KS3 = CN * 16 + 256;
constexpr float EPS = 1e-6f;

namespace pg8 {
constexpr int BM = 256, BK = 64, HALF = 128, HTB = HALF * BK * 2, STAGE_BYTES = 8 * HTB, NXCD = 8, WGM = 8;
__host__ __device__ __forceinline__ int lds_byte(int r, int c) { const int st = (r >> 4) * 2 + (c >> 5), rr = r & 15, cc = c & 31, ob = rr * 64 + cc * 2; return st * 1024 + (ob ^ (((ob >> 9) & 1) << 5)); }
__host__ __device__ __forceinline__ void stage_rc(int b, int& R, int& C) { const int st = b / 1024, sb = b % 1024, swz = sb ^ (((sb >> 9) & 1) << 5); R = (st >> 1) * 16 + swz / 64; C = (st & 1) * 32 + (swz % 64) / 2; }
__host__ __device__ __forceinline__ int perm32(int rho) { const int n = rho >> 4, i = rho & 15; return 8 * (i >> 2) + 4 * n + (i & 3); }

struct Unit { int pm, pn; long aoff, boff; };
struct Gemm { const bf16_t* A; const bf16_t* Bt; int K; unsigned a_rs, a_c16, a_kstep, b_rs; };

template <class Map> struct Order {
    int nM, nN, nwg, G, c; Map mp;
    __device__ __forceinline__ void init(int nM_, int nN_, int G_, int c_, const Map& m) { nM = nM_; nN = nN_; nwg = nM * nN; G = G_; c = c_; mp = m; }
    __device__ __forceinline__ bool next(int i, Unit& u) const {
        const long L = (long)i * G + c; if (L >= nwg) return false;
        int wgid = (int)L; { const int q = nwg / NXCD, r = nwg % NXCD, xcd = wgid % NXCD, off = wgid / NXCD; wgid = (xcd < r ? xcd * (q + 1) : r * (q + 1) + (xcd - r) * q) + off; }
        const int nig = WGM * nN, gid = wgid / nig, fm = gid * WGM, gsz = (nM - fm) < WGM ? (nM - fm) : WGM;
        const int pm = fm + ((wgid % nig) % gsz), pn = (wgid % nig) / gsz;
        mp.map(pm, pn, u); return true;
    }
};
struct MapG { long a_t, b_t; int grp_m, nNb, a_mod;
    __device__ __forceinline__ void map(int pm, int pn, Unit& u) const { u.pm = pm; u.pn = pn; u.aoff = (long)(pm % a_mod) * a_t; u.boff = (long)((pm / grp_m) * nNb + pn) * b_t; } };

__device__ __forceinline__ unsigned cvt_pk_bf16(float lo, float hi) { unsigned r; asm volatile("v_cvt_pk_bf16_f32 %0, %1, %2" : "=v"(r) : "v"(lo), "v"(hi)); return r; }
__device__ __forceinline__ u32x4 pack8(const f32x4 a, const f32x4 b) { u32x4 w; w.x = cvt_pk_bf16(a[0], a[1]); w.y = cvt_pk_bf16(a[2], a[3]); w.z = cvt_pk_bf16(b[0], b[1]); w.w = cvt_pk_bf16(b[2], b[3]); return w; }
__device__ __forceinline__ void unpack8(const u32x4 w, f32x4& a, f32x4& b) {
    a[0] = __uint_as_float(w.x << 16); a[1] = __uint_as_float(w.x & 0xffff0000u); a[2] = __uint_as_float(w.y << 16); a[3] = __uint_as_float(w.y & 0xffff0000u);
    b[0] = __uint_as_float(w.z << 16); b[1] = __uint_as_float(w.z & 0xffff0000u); b[2] = __uint_as_float(w.w << 16); b[3] = __uint_as_float(w.w & 0xffff0000u); }
__device__ __forceinline__ float row_rinv(const float* ssqp, int row) {
    const f32x4* p = (const f32x4*)(ssqp + (size_t)row * 16); const f32x4 a = p[0], b = p[1], c = p[2], d = p[3];
    const f32x4 s = (a + b) + (c + d); return __builtin_amdgcn_rsqf(((s[0] + s[1]) + (s[2] + s[3])) * (1.0f / 1024.0f) + EPS); }

#define EPI_ROWS_BEGIN _Pragma("unroll") for (int ai = 0; ai < 2; ++ai) _Pragma("unroll") for (int m = 0; m < 4; ++m) { const int rt = ai * 128 + wr * 64 + m * 16 + fr; const int row = u.pm * 256 + rt; (void)row;
#define EPI_ROWS_END }
#define EPI_COLS_BEGIN _Pragma("unroll") for (int bj = 0; bj < 2; ++bj) { const int ct = bj * 128 + wc * 32 + 8 * fq; (void)ct;
#define EPI_COLS_END }

struct EpiBf16Plain {
    static constexpr int MIN_VMEM = 16; static constexpr bool USE_RINV = false;
    bf16_t* O; int ldc;
    __device__ __forceinline__ void operator()(f32x4 (&acc)[2][2][4][2], const Unit& u, int wr, int wc, int fr, int fq, const LAS float* rt_) const {
        EPI_ROWS_BEGIN bf16_t* rowp = O + (size_t)row * ldc + u.pn * 256;
        EPI_COLS_BEGIN *(u32x4*)(rowp + ct) = pack8(acc[ai][bj][m][0], acc[ai][bj][m][1]); EPI_COLS_END
        EPI_ROWS_END }
};
struct EpiKV {
    static constexpr int MIN_VMEM = 16; static constexpr bool USE_RINV = false;
    bf16_t* Kb;
    __device__ __forceinline__ void operator()(f32x4 (&acc)[2][2][4][2], const Unit& u, int wr, int wc, int fr, int fq, const LAS float* rt_) const {
        EPI_ROWS_BEGIN bf16_t* rowp = Kb + (size_t)(u.pn >> 2) * (2 * MEMT * D) + (size_t)row * D + (u.pn & 3) * 256;
        EPI_COLS_BEGIN *(u32x4*)(rowp + ct) = pack8(acc[ai][bj][m][0], acc[ai][bj][m][1]); EPI_COLS_END
        EPI_ROWS_END }
};
struct EpiF32Plain {
    static constexpr int MIN_VMEM = 32; static constexpr bool USE_RINV = false;
    float* O; int ldc;
    __device__ __forceinline__ void operator()(f32x4 (&acc)[2][2][4][2], const Unit& u, int wr, int wc, int fr, int fq, const LAS float* rt_) const {
        EPI_ROWS_BEGIN float* rowp = O + (size_t)row * ldc + u.pn * 256;
        EPI_COLS_BEGIN *(f32x4*)(rowp + ct) = acc[ai][bj][m][0]; *(f32x4*)(rowp + ct + 4) = acc[ai][bj][m][1]; EPI_COLS_END
        EPI_ROWS_END }
};
struct EpiU {
    static constexpr int MIN_VMEM = 16; static constexpr bool USE_RINV = true;
    bf16_t* UX; const float* ssqp;
    __device__ __forceinline__ void operator()(f32x4 (&acc)[2][2][4][2], const Unit& u, int wr, int wc, int fr, int fq, const LAS float* rt_) const {
        EPI_ROWS_BEGIN const float ri = rt_[rt]; const int ch = row >> 5, tau = row & 31;
        EPI_COLS_BEGIN const int col = u.pn * 256 + ct, g = col >> 4, h0 = col & 15;
            *(u32x4*)(UX + ((size_t)g * NCH + ch) * KS3 + tau * 16 + h0) = pack8(acc[ai][bj][m][0] * ri, acc[ai][bj][m][1] * ri); EPI_COLS_END
        EPI_ROWS_END }
};
__device__ __forceinline__ float gelu_tanh(float x) {
    const float t = x * (0.7978845608f + 0.0356774081f * x * x);
    return x * __builtin_amdgcn_rcpf(1.0f + __builtin_amdgcn_exp2f(-2.8853900818f * t)); }
__device__ __forceinline__ float sigmoidf_(float x) { return __builtin_amdgcn_rcpf(1.0f + __builtin_amdgcn_exp2f(-1.4426950409f * x)); }
struct EpiGelu {
    static constexpr int MIN_VMEM = 16; static constexpr bool USE_RINV = false;
    bf16_t* O;
    __device__ __forceinline__ void operator()(f32x4 (&acc)[2][2][4][2], const Unit& u, int wr, int wc, int fr, int fq, const LAS float* rt_) const {
        EPI_ROWS_BEGIN bf16_t* rowp = O + (size_t)row * 512 + u.pn * 256;
        EPI_COLS_BEGIN f32x4 a = acc[ai][bj][m][0], b = acc[ai][bj][m][1];
#pragma unroll
            for (int e = 0; e < 4; ++e) { a[e] = gelu_tanh(a[e]); b[e] = gelu_tanh(b[e]); }
            *(u32x4*)(rowp + ct) = pack8(a, b); EPI_COLS_END
        EPI_ROWS_END }
};
struct EpiGlu {
    static constexpr int MIN_VMEM = 16; static constexpr bool USE_RINV = false;
    const bf16_t* Zgm; bf16_t* Z2;
    __device__ __forceinline__ void operator()(f32x4 (&acc)[2][2][4][2], const Unit& u, int wr, int wc, int fr, int fq, const LAS float* rt_) const {
        EPI_ROWS_BEGIN
        EPI_COLS_BEGIN const int col = u.pn * 256 + ct; const u32x4 zw = *(const u32x4*)(Zgm + ((size_t)(col >> 4) * T + row) * 16 + (col & 15));
            f32x4 za, zb; unpack8(zw, za, zb); f32x4 a = acc[ai][bj][m][0], b = acc[ai][bj][m][1];
#pragma unroll
            for (int e = 0; e < 4; ++e) { a[e] = za[e] * sigmoidf_(a[e]); b[e] = zb[e] * sigmoidf_(b[e]); }
            *(u32x4*)(Z2 + (size_t)row * D + col) = pack8(a, b); EPI_COLS_END
        EPI_ROWS_END }
};
struct EpiRes {
    static constexpr int MIN_VMEM = 32; static constexpr bool USE_RINV = false;
    bf16_t* Hb; float* ssqp;
    __device__ __forceinline__ void operator()(f32x4 (&acc)[2][2][4][2], const Unit& u, int wr, int wc, int fr, int fq, const LAS float* rt_) const {
        EPI_ROWS_BEGIN float ss = 0.f;
        EPI_COLS_BEGIN bf16_t* hp = Hb + (size_t)row * D + u.pn * 256 + ct; f32x4 ha, hb; unpack8(*(const u32x4*)hp, ha, hb);
            const f32x4 a = ha + acc[ai][bj][m][0], b = hb + acc[ai][bj][m][1];
            *(u32x4*)hp = pack8(a, b);
            ss += (a[0] * a[0] + a[1] * a[1]) + (a[2] * a[2] + a[3] * a[3]) + (b[0] * b[0] + b[1] * b[1]) + (b[2] * b[2] + b[3] * b[3]); EPI_COLS_END
            ss += __shfl_xor(ss, 16); ss += __shfl_xor(ss, 32);
            if (fq == 0) ssqp[(size_t)row * 16 + u.pn * 4 + wc] = ss;
        EPI_ROWS_END }
};
struct EpiRelu2 {
    static constexpr int MIN_VMEM = 16; static constexpr bool USE_RINV = true;
    bf16_t* O; const float* ssqp;
    __device__ __forceinline__ void operator()(f32x4 (&acc)[2][2][4][2], const Unit& u, int wr, int wc, int fr, int fq, const LAS float* rt_) const {
        EPI_ROWS_BEGIN const float ri = rt_[rt]; bf16_t* rowp = O + (size_t)row * FF + u.pn * 256;
        EPI_COLS_BEGIN f32x4 a = acc[ai][bj][m][0] * ri, b = acc[ai][bj][m][1] * ri;
#pragma unroll
            for (int e = 0; e < 4; ++e) { a[e] = fmaxf(a[e], 0.f); a[e] *= a[e]; b[e] = fmaxf(b[e], 0.f); b[e] *= b[e]; }
            *(u32x4*)(rowp + ct) = pack8(a, b); EPI_COLS_END
        EPI_ROWS_END }
};
struct EpiBCV {
    static constexpr int MIN_VMEM = 8; static constexpr bool USE_RINV = true;
    bf16_t* Zbv; bf16_t* Cg; const float* ssqp;
    __device__ __forceinline__ void operator()(f32x4 (&acc)[2][2][4][2], const Unit& u, int wr, int wc, int fr, int fq, const LAS float* rt_) const {
        if (u.pn < 8) {
            EPI_ROWS_BEGIN const float ri = rt_[rt], r2 = ri * ri;
                *(u32x4*)(Zbv + (size_t)row * D + u.pn * 128 + wc * 32 + 8 * fq) = pack8(acc[ai][0][m][0] * acc[ai][1][m][0] * r2, acc[ai][0][m][1] * acc[ai][1][m][1] * r2);
            EPI_ROWS_END
        } else {
            EPI_ROWS_BEGIN const float ri = rt_[rt]; bf16_t* rowp = Cg + (size_t)row * D + (u.pn - 8) * 256;
            EPI_COLS_BEGIN *(u32x4*)(rowp + ct) = pack8(acc[ai][bj][m][0] * ri, acc[ai][bj][m][1] * ri); EPI_COLS_END
            EPI_ROWS_END
        }
    }
};
struct EpiSoftmax {
    static constexpr int MIN_VMEM = 16; static constexpr bool USE_RINV = true;
    bf16_t* P; const float* ssqp; LAS f32x2* xch;
    __device__ __forceinline__ void operator()(f32x4 (&acc)[2][2][4][2], const Unit& u, int wr, int wc, int fr, int fq, const LAS float* rt_) const {
        EPI_ROWS_BEGIN const float ri = rt_[rt] * 1.4426950409f; float mx = -3.0e38f;
        EPI_COLS_BEGIN
#pragma unroll
            for (int n = 0; n < 2; ++n) { acc[ai][bj][m][n] = acc[ai][bj][m][n] * ri; const f32x4 v = acc[ai][bj][m][n]; mx = fmaxf(mx, fmaxf(fmaxf(v[0], v[1]), fmaxf(v[2], v[3]))); } EPI_COLS_END
            mx = fmaxf(mx, __shfl_xor(mx, 16)); mx = fmaxf(mx, __shfl_xor(mx, 32)); float sm = 0.f;
        EPI_COLS_BEGIN
#pragma unroll
            for (int n = 0; n < 2; ++n) { f32x4 v = acc[ai][bj][m][n];
#pragma unroll
                for (int e = 0; e < 4; ++e) { v[e] = __builtin_amdgcn_exp2f(v[e] - mx); sm += v[e]; } acc[ai][bj][m][n] = v; } EPI_COLS_END
            sm += __shfl_xor(sm, 16); sm += __shfl_xor(sm, 32);
            if (fq == 0) xch[rt * 4 + wc] = (f32x2){mx, sm};
            asm volatile("" ::: "memory");
        EPI_ROWS_END
        asm volatile("s_waitcnt lgkmcnt(0)" ::: "memory"); __builtin_amdgcn_s_barrier(); asm volatile("" ::: "memory");
        EPI_ROWS_BEGIN const f32x2 p0 = xch[rt * 4 + 0], p1 = xch[rt * 4 + 1], p2 = xch[rt * 4 + 2], p3 = xch[rt * 4 + 3];
            const float M = fmaxf(fmaxf(p0.x, p1.x), fmaxf(p2.x, p3.x));
            const float Ls = (p0.y * __builtin_amdgcn_exp2f(p0.x - M) + p1.y * __builtin_amdgcn_exp2f(p1.x - M)) + (p2.y * __builtin_amdgcn_exp2f(p2.x - M) + p3.y * __builtin_amdgcn_exp2f(p3.x - M));
            const float mown = wc == 0 ? p0.x : wc == 1 ? p1.x : wc == 2 ? p2.x : p3.x;
            const float f = __builtin_amdgcn_exp2f(mown - M) * __builtin_amdgcn_rcpf(Ls); bf16_t* rowp = P + (size_t)row * D + u.pn * 256;
        EPI_COLS_BEGIN *(u32x4*)(rowp + ct) = pack8(acc[ai][bj][m][0] * f, acc[ai][bj][m][1] * f); EPI_COLS_END
            asm volatile("" ::: "memory");
        EPI_ROWS_END
        asm volatile("s_waitcnt lgkmcnt(0)" ::: "memory"); __builtin_amdgcn_s_barrier(); asm volatile("" ::: "memory");
    }
};

template <class Epi, class Sched>
__device__ __forceinline__ void gemm_phase(LAS unsigned char* lds, const Gemm g, const Sched& S, const Epi& E, const int wid, LAS float* rtab = nullptr) {
    int lane = __builtin_amdgcn_mbcnt_hi(~0u, __builtin_amdgcn_mbcnt_lo(~0u, 0u)); asm volatile("" : "+v"(lane));
    const int tid = wid * 64 + lane, wr = wid >> 2, wc = wid & 3, fr = lane & 15, fq = lane >> 4;
    const int nt = g.K / BK;
    unsigned voffA[2], voffB[2];
#pragma unroll
    for (int i = 0; i < 2; ++i) { int R, C; stage_rc(tid * 16 + i * 8192, R, C); const int Rb = (R & ~31) + perm32(R & 31);
        voffA[i] = (unsigned)R * g.a_rs + (unsigned)(C >> 4) * g.a_c16 + (unsigned)(C & 15) * 2u; voffB[i] = (unsigned)Rb * g.b_rs + (unsigned)C * 2u; }
    const size_t kstepA = (size_t)g.a_kstep, kstepB = (size_t)(BK * 2);
    const size_t hstepA = (size_t)HALF * g.a_rs, hstepB = (size_t)HALF * g.b_rs;
    const unsigned ldsw = (unsigned)wid * 1024u;
    const int aoff = lds_byte(wr * 64 + fr, fq * 8), boff = lds_byte(wc * 32 + fr, fq * 8);
#define PG8_SA(b, h) (((b) * 2 + (h)) * HTB)
#define PG8_SB(b, h) ((4 + (b) * 2 + (h)) * HTB)
#define PG8_STAGE(bufoff, gbase, voff) do { _Pragma("unroll") for (int _i = 0; _i < 2; ++_i) \
        __builtin_amdgcn_global_load_lds((const unsigned*)((const char*)(gbase) + (voff)[_i]), (LAS unsigned*)(lds + (bufoff) + ldsw + _i * 8192), 16, 0, 0); } while (0)
#define PG8_LDA(dst, b, h) do { _Pragma("unroll") for (int m = 0; m < 4; ++m) _Pragma("unroll") for (int k = 0; k < 2; ++k) dst[m][k] = *(const LAS bf16x8*)(lds + PG8_SA(b, h) + aoff + m * 2048 + k * 1024); } while (0)
#define PG8_LDB(dst, b, h) do { _Pragma("unroll") for (int n = 0; n < 2; ++n) _Pragma("unroll") for (int k = 0; k < 2; ++k) dst[n][k] = *(const LAS bf16x8*)(lds + PG8_SB(b, h) + boff + n * 2048 + k * 1024); } while (0)
#define PG8_MMA(ai, bj, At, Bt) do { __builtin_amdgcn_s_setprio(1); _Pragma("unroll") for (int m = 0; m < 4; ++m) _Pragma("unroll") for (int n = 0; n < 2; ++n) _Pragma("unroll") for (int k = 0; k < 2; ++k) \
        acc[ai][bj][m][n] = __builtin_amdgcn_mfma_f32_16x16x32_bf16(Bt[n][k], At[m][k], acc[ai][bj][m][n], 0, 0, 0); __builtin_amdgcn_s_setprio(0); } while (0)
#define PG8_WAIT_V(n) asm volatile("s_waitcnt vmcnt(" #n ")" ::: "memory")
#define PG8_WAIT_VF() do { if (fk) asm volatile("s_waitcnt vmcnt(%0)" :: "n"(8 + Epi::MIN_VMEM) : "memory"); else asm volatile("s_waitcnt vmcnt(8)" ::: "memory"); } while (0)
#define PG8_WAIT_L(n) asm volatile("s_waitcnt lgkmcnt(" #n ")" ::: "memory")
#define PG8_BAR __builtin_amdgcn_s_barrier()
#define PG8_SCHED __builtin_amdgcn_sched_barrier(0)
    Unit cur, nxt; int ui = 0;
    if (!S.next(0, cur)) return;
    if constexpr (Epi::USE_RINV) { Unit tu; for (int i = 0; S.next(i, tu); ++i) if (tid < 256) rtab[i * 256 + tid] = row_rinv(E.ssqp, tu.pm * 256 + tid); }
    f32x4 acc[2][2][4][2];
#pragma unroll
    for (int a = 0; a < 2; ++a)
#pragma unroll
        for (int b = 0; b < 2; ++b)
#pragma unroll
            for (int m = 0; m < 4; ++m)
#pragma unroll
                for (int n = 0; n < 2; ++n) acc[a][b][m][n] = (f32x4){0.f, 0.f, 0.f, 0.f};
    bf16x8 At[4][2], B0[2][2], B1[2][2];
    const char* cA = (const char*)g.A + cur.aoff; const char* cB = (const char*)g.Bt + cur.boff;
    PG8_STAGE(PG8_SB(0, 0), cB, voffB); PG8_STAGE(PG8_SB(0, 1), cB + hstepB, voffB); PG8_STAGE(PG8_SA(0, 0), cA, voffA); PG8_STAGE(PG8_SA(0, 1), cA + hstepA, voffA);
    if (wr == 1) PG8_BAR;
    PG8_WAIT_V(2); PG8_BAR;
    PG8_STAGE(PG8_SB(1, 0), cB + kstepB, voffB); PG8_STAGE(PG8_SA(1, 0), cA + kstepA, voffA); PG8_STAGE(PG8_SB(1, 1), cB + hstepB + kstepB, voffB);
    PG8_WAIT_V(6); PG8_BAR;
#pragma nounroll
    for (;;) {
        const bool has_next = S.next(ui + 1, nxt);
        const char* nA = has_next ? (const char*)g.A + nxt.aoff : cA; const char* nB = has_next ? (const char*)g.Bt + nxt.boff : cB;
#pragma nounroll
        for (int t = 0; t < nt; t += 2) {
            const bool last = (t == nt - 2);
            const char* a1 = cA + (size_t)(t + 1) * kstepA;
            const char* a2 = last ? nA : cA + (size_t)(t + 2) * kstepA; const char* b2 = last ? nB : cB + (size_t)(t + 2) * kstepB;
            const char* a3 = a2 + kstepA; const char* b3 = b2 + kstepB;
            const bool fk = (ui > 0) && (t == 0);
            PG8_LDB(B0, 0, 0); PG8_LDB(B1, 0, 1); PG8_SCHED; PG8_LDA(At, 0, 0); if (!fk) PG8_STAGE(PG8_SA(1, 1), a1 + hstepA, voffA);
            PG8_WAIT_VF(); PG8_WAIT_L(0); PG8_BAR; PG8_MMA(0, 0, At, B0); PG8_MMA(0, 1, At, B1); PG8_BAR; PG8_SCHED;
            PG8_LDA(At, 0, 1); PG8_STAGE(PG8_SB(0, 0), b2, voffB); PG8_STAGE(PG8_SB(0, 1), b2 + hstepB, voffB); PG8_STAGE(PG8_SA(0, 0), a2, voffA);
            PG8_WAIT_VF(); PG8_WAIT_L(0); PG8_BAR; PG8_MMA(1, 0, At, B0); PG8_MMA(1, 1, At, B1); PG8_BAR; PG8_SCHED;
            PG8_LDB(B0, 1, 0); PG8_LDB(B1, 1, 1); PG8_SCHED; PG8_LDA(At, 1, 0); PG8_STAGE(PG8_SA(0, 1), a2 + hstepA, voffA);
            PG8_WAIT_VF(); PG8_WAIT_L(0); PG8_BAR; PG8_MMA(0, 0, At, B0); PG8_MMA(0, 1, At, B1); PG8_BAR; PG8_SCHED;
            PG8_LDA(At, 1, 1); PG8_STAGE(PG8_SB(1, 0), b3, voffB); PG8_STAGE(PG8_SB(1, 1), b3 + hstepB, voffB); PG8_STAGE(PG8_SA(1, 0), a3, voffA);
            PG8_WAIT_V(8); PG8_WAIT_L(0); PG8_BAR; PG8_MMA(1, 0, At, B0); PG8_MMA(1, 1, At, B1); PG8_BAR; PG8_SCHED;
        }
        if (wr == 0) PG8_BAR;
        if (has_next) PG8_STAGE(PG8_SA(1, 1), nA + kstepA + hstepA, voffA);
        E(acc, cur, wr, wc, fr, fq, rtab + ui * 256);
        if (!has_next) break;
#pragma unroll
        for (int a = 0; a < 2; ++a)
#pragma unroll
            for (int b = 0; b < 2; ++b)
#pragma unroll
                for (int m = 0; m < 4; ++m)
#pragma unroll
                    for (int n = 0; n < 2; ++n) acc[a][b][m][n] = (f32x4){0.f, 0.f, 0.f, 0.f};
        cur = nxt; cA = nA; cB = nB; ++ui;
        if (wr == 1) PG8_BAR;
    }
    PG8_WAIT_V(0);
    PG8_BAR;
#undef PG8_SA
#undef PG8_SB
#undef PG8_STAGE
#undef PG8_LDA
#undef PG8_LDB
#undef PG8_MMA
#undef PG8_WAIT_V
#undef PG8_WAIT_VF
#undef PG8_WAIT_L
#undef PG8_BAR
#undef PG8_SCHED
}
}

constexpr size_t MiB = 1u << 20;
constexpr size_t WS_CTL = 0, CTL_ZERO_BYTES = 64 * 1024;
constexpr size_t WS_WINT = 1 * MiB, WS_WGLUT = 3 * MiB, WS_WOUTT = 5 * MiB, WS_BINT = 7 * MiB, WS_BOUTT = 13 * MiB, WS_WQN = 15 * MiB, WS_WOT = 19 * MiB,
                 WS_WKVT = 23 * MiB, WS_W1T = 31 * MiB, WS_W2T = 47 * MiB;
constexpr size_t WS_MEMN = 63 * MiB, WS_KV = 65 * MiB, WS_WEFFT = 73 * MiB, WS_VWT = 89 * MiB, WS_HB = 105 * MiB, WS_SSQP = 169 * MiB;
constexpr size_t WS_WS = 171 * MiB, WS_W3 = 187 * MiB, WS_UX = 235 * MiB, WS_S = 331 * MiB, WS_ZGM = 395 * MiB;
constexpr size_t WS_Z2 = 235 * MiB, WS_P = 171 * MiB, WS_AFF = 235 * MiB, WS_ZBV = 235 * MiB, WS_CG = 299 * MiB, WS_ZC = 363 * MiB;
constexpr size_t WS_KTAB = 492 * MiB, WS_APW = 496 * MiB, WS_CCG = 499 * MiB, WS_END = 500 * MiB;
constexpr size_t WS_KB = WS_KV, WS_VB = WS_KV + 4 * MiB;
constexpr int CW_BAR = 4096;
constexpr int RING_BYTES = 131072, XCH_OFF = RING_BYTES, LDS_BYTES = 163840, MISC_OFF = LDS_BYTES - 256;
constexpr int NWAVES = 8;

#define RLX_AGENT __ATOMIC_RELAXED, __HIP_MEMORY_SCOPE_AGENT
#define LDS_WAIT() asm volatile("s_waitcnt lgkmcnt(0)" ::: "memory")
#define VM_WAIT() asm volatile("s_waitcnt vmcnt(0)" ::: "memory")

#define XB_TMO      128
#define XB_XCNT(j)  (256  + 64 * (j))
#define XB_XSUB(j)  (1280 + 64 * (j))
#define XB_XGEN(j)  (2304 + 64 * (j))
#define XB_TOP      3328
#define XB_TOPGEN   3392
#define XCD_BAR_WORDS 3456
#define XB_SPIN_CAP (1u << 20)
__device__ __forceinline__ unsigned xb_ld(unsigned* p)              { return __hip_atomic_load(p, __ATOMIC_RELAXED, __HIP_MEMORY_SCOPE_AGENT); }
__device__ __forceinline__ unsigned xb_add(unsigned* p, unsigned v) { return __hip_atomic_fetch_add(p, v, __ATOMIC_RELAXED, __HIP_MEMORY_SCOPE_AGENT); }
__device__ __forceinline__ unsigned xb_xcc_id() { return (unsigned)__builtin_amdgcn_s_getreg((3 << 11) | 20) & 0xFu; }
#define XB_SPIN(cond, bar) do { unsigned _sp = 0; while (cond) { __builtin_amdgcn_s_sleep(1); \
    if ((++_sp & 255u) == 0u) { if (xb_ld(&(bar)[XB_TMO])) break; if (_sp > XB_SPIN_CAP) { atomicAdd(&(bar)[XB_TMO], 1u); break; } } } } while (0)
struct XcdBarrier { unsigned* bar; unsigned x; volatile LAS unsigned* st; };
__device__ __forceinline__ XcdBarrier xcd_barrier_post(unsigned* bar, volatile LAS unsigned* st) {
    XcdBarrier b; b.bar = bar; b.x = xb_xcc_id(); b.st = st;
    if (threadIdx.x == 0) (void)xb_add(&bar[XB_XCNT(b.x)], 1u);
    return b;
}
__device__ __forceinline__ void xcd_barrier_complete(unsigned* bar, unsigned x, unsigned& nloc, unsigned& nx) {
    const unsigned G = gridDim.x * gridDim.y * gridDim.z;
    unsigned sum, cnt, mine, sp = 0u;
    for (;;) {
        sum = 0u; cnt = 0u; mine = 0u;
#pragma unroll
        for (unsigned j = 0; j < 16; ++j) { const unsigned c = xb_ld(&bar[XB_XCNT(j)]); sum += c; cnt += (c > 0u) ? 1u : 0u; mine = (j == x) ? c : mine; }
        if (sum == G) break;
        __builtin_amdgcn_s_sleep(1);
        if ((++sp & 255u) == 0u) { if (xb_ld(&bar[XB_TMO])) break; if (sp > XB_SPIN_CAP) { atomicAdd(&bar[XB_TMO], 1u); break; } }
    }
    nloc = mine > 0u ? mine : 1u; nx = cnt > 0u ? cnt : 1u;
}
__device__ __forceinline__ int lane_id() { return __builtin_amdgcn_mbcnt_hi(~0u, __builtin_amdgcn_mbcnt_lo(~0u, 0u)); }
__device__ __forceinline__ void xcd_barrier(const XcdBarrier& b, const int wv) {
    asm volatile("s_waitcnt vmcnt(0)" ::: "memory");
    __syncthreads();
    if (wv == 0 && lane_id() == 0) {
        unsigned* bar = b.bar;
        __builtin_amdgcn_s_waitcnt(0);
        unsigned nloc = b.st[0], nx = b.st[1];
        if (nloc == 0u) { xcd_barrier_complete(bar, b.x, nloc, nx); b.st[0] = nloc; b.st[1] = nx; }
        const unsigned old = xb_add(&bar[XB_XSUB(b.x)], 1u);
        const unsigned gen = old / nloc;
        if (old + 1u == (gen + 1u) * nloc) {
            __builtin_amdgcn_fence(__ATOMIC_RELEASE, "agent");
            asm volatile("s_waitcnt vmcnt(0)" ::: "memory");
            const unsigned og = xb_add(&bar[XB_TOP], 1u);
            const unsigned tg = og / nx;
            if (og + 1u == (tg + 1u) * nx) xb_add(&bar[XB_TOPGEN], 1u);
            else XB_SPIN(xb_ld(&bar[XB_TOPGEN]) == tg, bar);
            __builtin_amdgcn_fence(__ATOMIC_ACQUIRE, "agent");
            xb_add(&bar[XB_XGEN(b.x)], 1u);
            asm volatile("s_waitcnt vmcnt(0)" ::: "memory");
        } else {
            XB_SPIN(xb_ld(&bar[XB_XGEN(b.x)]) == gen, bar);
            __builtin_amdgcn_fence(__ATOMIC_ACQUIRE, "agent");
            asm volatile("s_waitcnt vmcnt(0)" ::: "memory");
        }
    }
    __syncthreads();
}

__device__ __forceinline__ float wave_sum(float v) {
#pragma unroll
    for (int o = 1; o < 64; o <<= 1) v += __shfl_xor(v, o);
    return v;
}
using pg8::cvt_pk_bf16;
__device__ __forceinline__ void transpose_item(const float* W, int ldw, int k0, int n0, const float* gain, bf16_t* WT, int K, int drow0, LAS float* scr, int lane) {
    float v[32];
#pragma unroll
    for (int i = 0; i < 32; ++i) v[i] = W[(size_t)(k0 + 2 * i + (lane >> 5)) * ldw + n0 + (lane & 31)];
    if (gain) {
#pragma unroll
        for (int i = 0; i < 32; ++i) v[i] *= gain[k0 + 2 * i + (lane >> 5)]; }
#pragma unroll
    for (int i = 0; i < 32; ++i) scr[(2 * i + (lane >> 5)) * 33 + (lane & 31)] = v[i];
    LDS_WAIT(); asm volatile("" ::: "memory");
    const int c = lane & 7;
#pragma unroll
    for (int j = 0; j < 4; ++j) { const int n = (lane >> 3) + 8 * j; const LAS float* s = scr + (8 * c) * 33 + n;
        u32x4 o; o.x = cvt_pk_bf16(s[0 * 33], s[1 * 33]); o.y = cvt_pk_bf16(s[2 * 33], s[3 * 33]); o.z = cvt_pk_bf16(s[4 * 33], s[5 * 33]); o.w = cvt_pk_bf16(s[6 * 33], s[7 * 33]);
        *(u32x4*)(WT + (size_t)(drow0 + n) * K + k0 + 8 * c) = o; }
    LDS_WAIT(); asm volatile("" ::: "memory");
}
__device__ __forceinline__ bool transpose_job(int& r, const float* W, int K, int N, const float* gain, bf16_t* WT, int kind, LAS float* scr, int lane) {
    const int nblk = N / 32, items = (K / 64) * nblk;
    if (r >= items) { r -= items; return false; }
    const int kb = r / nblk, nb = r % nblk, n0 = nb * 32; int drow0 = n0;
    if (kind == 1) { if (n0 < 1024) drow0 = 256 * (n0 >> 7) + (n0 & 127); else if (n0 < 2048) drow0 = 2048 + (n0 - 1024); else drow0 = 256 * ((n0 - 2048) >> 7) + 128 + ((n0 - 2048) & 127); }
    transpose_item(W, N, kb * 64, n0, gain, WT, K, drow0, scr, lane); return true;
}

typedef f32x2 cf;
__device__ __forceinline__ cf mkcf(float a, float b) { cf r; r.x = a; r.y = b; return r; }
__device__ __forceinline__ cf cmul(cf a, cf b) { return mkcf(a.x * b.x - a.y * b.y, a.x * b.y + a.y * b.x); }

__device__ __forceinline__ void ssm_tables_a(LAS unsigned char* lds, int g, int q, const float* lre, const float* lim, const float* logdt, const float* bre, const float* bim,
                                             const float* cre, const float* cim, bf16_t* WS, float* Ktab, cf* APW, cf* CCG, const int tid) {
    LAS cf* apow = (LAS cf*)lds; LAS cf* Bb = apow + 2 * 33 * 64; LAS cf* Cc = Bb + 2 * 64 * 16;
    for (int idx = tid; idx < 2 * 33 * 64; idx += 512) { const int r = idx / 2112, k = (idx % 2112) >> 6, p = idx & 63, gi = (r * 64 + g) * 64 + p;
        const float dt = expf(logdt[r * 64 + g]), x = lre[gi] * dt, y = lim[gi] * dt, mag = expf((float)k * x), ang = (float)k * y; apow[idx] = mkcf(mag * cosf(ang), mag * sinf(ang)); }
    for (int j = 0; j < 4; ++j) { const int idx = tid + 512 * j, r = idx >> 10, p = (idx >> 4) & 63, h = idx & 15, gi = (r * 64 + g) * 64 + p;
        const float lr = lre[gi], li = lim[gi], dt = expf(logdt[r * 64 + g]), x = lr * dt, y = li * dt;
        const float sh = sinf(0.5f * y); const cf am1 = mkcf(expm1f(x) * cosf(y) - 2.0f * sh * sh, expf(x) * sinf(y));
        const float den = 1.0f / (lr * lr + li * li); const cf coef = mkcf((am1.x * lr + am1.y * li) * den, (am1.y * lr - am1.x * li) * den);
        Bb[idx] = cmul(coef, mkcf(bre[(size_t)gi * 16 + h], bim[(size_t)gi * 16 + h])); }
    for (int j = 0; j < 4; ++j) { const int idx = tid + 512 * j, r = idx >> 10, h = (idx >> 6) & 15, p = idx & 63; const size_t gi = ((size_t)(r * 64 + g) * 16 + h) * 64 + p; Cc[idx] = mkcf(cre[gi], cim[gi]); }
    __syncthreads();
    {
        const int r = q >> 1, im = q & 1;
        for (int j = 0; j < 8; ++j) { const int idx = tid + 512 * j, p = idx >> 6, kc = idx & 63, s = kc >> 1, h0 = (kc & 1) * 8, e = r == 0 ? 31 - s : s;
            const cf ap = apow[(r * 33 + e) * 64 + p]; float v[8];
#pragma unroll
            for (int i = 0; i < 8; ++i) { const cf z = cmul(ap, Bb[(r * 64 + p) * 16 + h0 + i]); v[i] = im ? z.y : z.x; }
            u32x4 o; o.x = cvt_pk_bf16(v[0], v[1]); o.y = cvt_pk_bf16(v[2], v[3]); o.z = cvt_pk_bf16(v[4], v[5]); o.w = cvt_pk_bf16(v[6], v[7]);
            *(u32x4*)(WS + ((size_t)(g * 256 + 64 * q + p) * KS1 + kc * 8)) = o; }
    }
    {
        const int r = tid >> 8, h = (tid >> 4) & 15, hp = tid & 15; float acc[8];
#pragma unroll
        for (int k = 0; k < 8; ++k) acc[k] = 0.f;
        for (int p = 0; p < 64; ++p) { const cf cb = cmul(Cc[(r * 16 + h) * 64 + p], Bb[(r * 64 + p) * 16 + hp]);
#pragma unroll
            for (int k = 0; k < 8; ++k) { const cf ap = apow[(r * 33 + 8 * q + k) * 64 + p]; acc[k] += cb.x * ap.x - cb.y * ap.y; } }
#pragma unroll
        for (int k = 0; k < 8; ++k) Ktab[((size_t)(g * 2 + r) * 32 + 8 * q + k) * 256 + h * 16 + hp] = acc[k];
    }
    if (q == 0) {
        for (int idx = tid; idx < 2 * 33 * 64; idx += 512) APW[(size_t)g * 2 * 33 * 64 + idx] = apow[idx];
        for (int idx = tid; idx < 2 * 16 * 64; idx += 512) CCG[(size_t)g * 2 * 16 * 64 + idx] = Cc[idx];
    }
    __syncthreads();
}
__device__ __forceinline__ void ssm_tables_b_load(LAS unsigned char* lds, int g, int q, const float* Ktab, const cf* APW, const cf* CCG, const int tid) {
    LAS f32x4* Kt4 = (LAS f32x4*)lds; LAS cf* AP8 = (LAS cf*)(lds + 65536); LAS cf* Cc = AP8 + 2 * 8 * 64;
    const f32x4* ks = (const f32x4*)(Ktab + (size_t)g * 2 * 32 * 256);
#pragma unroll
    for (int j = 0; j < 8; ++j) Kt4[tid + 512 * j] = ks[tid + 512 * j];
    for (int idx = tid; idx < 2 * 8 * 64; idx += 512) { const int r = idx >> 9, i = (idx >> 6) & 7, p = idx & 63, tau = 8 * q + i, e = r ? 32 - tau : tau + 1; AP8[idx] = APW[((size_t)(g * 2 + r) * 33 + e) * 64 + p]; }
    for (int idx = tid; idx < 2 * 16 * 64; idx += 512) Cc[idx] = CCG[(size_t)g * 2 * 16 * 64 + idx];
}
__device__ __forceinline__ void ssm_tables_b_write(LAS unsigned char* lds, int g, int q, int ft  , const float* dd, bf16_t* W3) {
    const LAS float* Kt = (const LAS float*)lds; const LAS cf* AP8 = (const LAS cf*)(lds + 65536); const LAS cf* Cc = AP8 + 2 * 8 * 64;
    for (int j = 0; j < 32; ++j) { const int idx = ft + 384 * j, lrow = idx / 96, kc = idx % 96, n = 128 * q + lrow, tau = n >> 4, h = n & 15, k0 = kc * 8; float v[8];
        if (k0 < 512) { const int s = kc >> 1, h0 = (kc & 1) * 8;
#pragma unroll
            for (int i = 0; i < 8; ++i) { const int hp = h0 + i; float t = 0.f; if (s <= tau) t += Kt[(tau - s) * 256 + h * 16 + hp]; if (s >= tau) t += Kt[(32 + s - tau) * 256 + h * 16 + hp];
                if (s == tau && h == hp) t += dd[g * 16 + h]; v[i] = t; }
        } else { const int r = k0 >= 640 ? 1 : 0, rel = k0 - (r ? 640 : 512), im = rel >> 6, p0 = rel & 63;
#pragma unroll
            for (int i = 0; i < 8; ++i) { const cf z = cmul(Cc[(r * 16 + h) * 64 + p0 + i], AP8[(r * 8 + (tau - 8 * q)) * 64 + p0 + i]); v[i] = im ? -z.y : z.x; } }
        u32x4 o; o.x = cvt_pk_bf16(v[0], v[1]); o.y = cvt_pk_bf16(v[2], v[3]); o.z = cvt_pk_bf16(v[4], v[5]); o.w = cvt_pk_bf16(v[6], v[7]);
        *(u32x4*)(W3 + ((size_t)(g * 512 + n) * KS3 + k0)) = o; }
}

struct Args { const float* in[26]; float* out; unsigned char* ws; int ph_lo, ph_hi, li, pad; };
constexpr int N_PHASES = 19;
#ifndef MK_N_LAUNCHES
#define MK_N_LAUNCHES 1
#endif

__global__ void __launch_bounds__(NWAVES * 64, 2) trunk_fwd(Args args) {
    extern __shared__ __attribute__((aligned(16))) unsigned char lds_raw[];
    LAS unsigned char* lds = (LAS unsigned char*)lds_raw;
    volatile LAS unsigned* MISC = (volatile LAS unsigned*)(lds + MISC_OFF);
    const int G = gridDim.x, bx = blockIdx.x, vcu = (G % 8 == 0) ? (bx % 8) * (G / 8) + bx / 8 : bx, NGW = G * NWAVES;
    const int wv = __builtin_amdgcn_readfirstlane(threadIdx.x >> 6);
#define PHASE_IDS int lane = __builtin_amdgcn_mbcnt_hi(~0u, __builtin_amdgcn_mbcnt_lo(~0u, 0u)); asm volatile("" : "+v"(lane)); const int wave = wv, tid = wv * 64 + lane, gw = vcu * NWAVES + wave; (void)tid; (void)gw;
    unsigned char* ws = args.ws;
    unsigned* ctl = (unsigned*)(ws + WS_CTL);
    if (threadIdx.x < 64) MISC[threadIdx.x] = 0u;
    __syncthreads();
    XcdBarrier bar; bar.bar = ctl + CW_BAR; bar.x = 0; bar.st = nullptr;
    if (MK_N_LAUNCHES == 1) bar = xcd_barrier_post(ctl + CW_BAR, MISC + 8);
    const int lo = args.ph_lo, hi = args.ph_hi;
#ifndef PH_MASK
#define PH_MASK 0xFFFFFFFFu
#endif
#define IN(k) (((PH_MASK >> (((k) >= 14 && (k) <= 17) ? (k) - 7 : (k))) & 1u) && lo <= (k) && (k) < hi)
#ifndef TPROBE
#define TPROBE -1
#endif
    unsigned long long tp0 = 0, tp1 = 0;
    if (TPROBE == 0) tp0 = __builtin_amdgcn_s_memrealtime();
#define SEAM(k) do { if (lo <= (k) && (k) + 1 < hi) xcd_barrier(bar, wv); if (TPROBE >= 0) { if ((k) == TPROBE - 1) tp0 = __builtin_amdgcn_s_memrealtime(); if ((k) == TPROBE) tp1 = __builtin_amdgcn_s_memrealtime(); } } while (0)

    const float* x = args.in[0]; const float* mem = args.in[1]; const float* norm_mix = args.in[2]; const float* norm_xattn = args.in[3]; const float* norm_mem = args.in[4];
    const float* norm_ffn = args.in[5]; const float* norm_final = args.in[6];
    float* H = args.out;
    bf16_t* WinT = (bf16_t*)(ws + WS_WINT); bf16_t* WgluT = (bf16_t*)(ws + WS_WGLUT); bf16_t* WoutT = (bf16_t*)(ws + WS_WOUTT); bf16_t* BinT = (bf16_t*)(ws + WS_BINT); bf16_t* BoutT = (bf16_t*)(ws + WS_BOUTT);
    bf16_t* WqN = (bf16_t*)(ws + WS_WQN); bf16_t* WoT = (bf16_t*)(ws + WS_WOT); bf16_t* WkvT = (bf16_t*)(ws + WS_WKVT); bf16_t* W1T = (bf16_t*)(ws + WS_W1T); bf16_t* W2T = (bf16_t*)(ws + WS_W2T);
    bf16_t* memn = (bf16_t*)(ws + WS_MEMN); bf16_t* WeffT = (bf16_t*)(ws + WS_WEFFT); bf16_t* VWT = (bf16_t*)(ws + WS_VWT);
    bf16_t* Hb = (bf16_t*)(ws + WS_HB); float* ssqp = (float*)(ws + WS_SSQP);
    bf16_t* WSs = (bf16_t*)(ws + WS_WS); bf16_t* W3 = (bf16_t*)(ws + WS_W3); bf16_t* UX = (bf16_t*)(ws + WS_UX); float* Ssum = (float*)(ws + WS_S); bf16_t* Zgm = (bf16_t*)(ws + WS_ZGM);
    bf16_t* Z2 = (bf16_t*)(ws + WS_Z2); bf16_t* Pm = (bf16_t*)(ws + WS_P); bf16_t* Aff = (bf16_t*)(ws + WS_AFF); bf16_t* Zbv = (bf16_t*)(ws + WS_ZBV); bf16_t* Cg = (bf16_t*)(ws + WS_CG); bf16_t* Zc = (bf16_t*)(ws + WS_ZC);
    constexpr int BIG = 1 << 30;
    LAS float* RT = (LAS float*)(lds + XCH_OFF + 8192);
    constexpr long TS2K = 256L * 2048;

    float* Ktab = (float*)(ws + WS_KTAB); cf* APW = (cf*)(ws + WS_APW); cf* CCG = (cf*)(ws + WS_CCG); bf16_t* Kb = (bf16_t*)(ws + WS_KB);
    if (IN(0)) {
        PHASE_IDS
        for (int it = vcu; it < 4 * NG; it += G)
            ssm_tables_a(lds, it >> 2, it & 3, args.in[8], args.in[9], args.in[10], args.in[11], args.in[12], args.in[13], args.in[14], WSs, Ktab, APW, CCG, tid);
        for (int t4 = gw * 4; t4 < T; t4 += NGW * 4) { f32x4 v[4][4];
#pragma unroll
            for (int i = 0; i < 4; ++i) { const f32x4* src = (const f32x4*)(x + (size_t)(t4 + i) * D) + lane;
#pragma unroll
                for (int j = 0; j < 4; ++j) v[i][j] = src[64 * j]; }
#pragma unroll
            for (int i = 0; i < 4; ++i) { u32x2* dst = (u32x2*)(Hb + (size_t)(t4 + i) * D) + lane; float s = 0.f;
#pragma unroll
                for (int j = 0; j < 4; ++j) { const f32x4 w = v[i][j]; s += (w[0] * w[0] + w[1] * w[1]) + (w[2] * w[2] + w[3] * w[3]); u32x2 o; o.x = cvt_pk_bf16(w[0], w[1]); o.y = cvt_pk_bf16(w[2], w[3]); dst[64 * j] = o; }
                s = wave_sum(s); if (lane < 16) ssqp[(size_t)(t4 + i) * 16 + lane] = lane == 0 ? s : 0.f; } }
        for (int t = gw; t < MEMT; t += NGW) { const f32x4* src = (const f32x4*)(mem + (size_t)t * D) + lane; u32x2* dst = (u32x2*)(memn + (size_t)t * D) + lane; f32x4 v[4]; float s = 0.f;
#pragma unroll
            for (int j = 0; j < 4; ++j) { v[j] = src[64 * j]; s += (v[j][0] * v[j][0] + v[j][1] * v[j][1]) + (v[j][2] * v[j][2] + v[j][3] * v[j][3]); }
            const float ri = __builtin_amdgcn_rsqf(wave_sum(s) * (1.0f / D) + EPS);
#pragma unroll
            for (int j = 0; j < 4; ++j) { u32x2 o; o.x = cvt_pk_bf16(v[j][0] * ri, v[j][1] * ri); o.y = cvt_pk_bf16(v[j][2] * ri, v[j][3] * ri); dst[64 * j] = o; } }
        for (int rw = gw; rw < 2 * D; rw += NGW) { const float gsc = norm_xattn[rw] * 0.0625f; const f32x4* src = (const f32x4*)(args.in[21] + (size_t)rw * D) + lane; u32x2* dst = (u32x2*)(WqN + (size_t)rw * D) + lane;
#pragma unroll
            for (int j = 0; j < 4; ++j) { const f32x4 v = src[64 * j] * gsc; u32x2 o; o.x = cvt_pk_bf16(v[0], v[1]); o.y = cvt_pk_bf16(v[2], v[3]); dst[64 * j] = o; } }
        LAS float* scr = (LAS float*)(lds + wave * 16384);
        constexpr int I_DD = 16 * 32, I_KV = 16 * 64;
        for (int it = gw; it < 3 * I_DD + 2 * I_KV; it += NGW) {
            int r = it;
            if (transpose_job(r, args.in[7], D, D, norm_mix, WinT, 0, scr, lane)) continue;
            if (transpose_job(r, args.in[22], D, 2 * D, norm_mem, WkvT, 0, scr, lane)) continue;
            if (transpose_job(r, args.in[22] + (size_t)D * 2 * D, D, 2 * D, norm_mem + D, WkvT + (size_t)2 * D * D, 0, scr, lane)) continue;
            if (transpose_job(r, args.in[23], D, D, nullptr, WoT, 0, scr, lane)) continue;
            transpose_job(r, args.in[23] + (size_t)D * D, D, D, nullptr, WoT + (size_t)D * D, 0, scr, lane);
        }
        SEAM(0);
    }
    if (IN(1)) {
        { pg8::Gemm g{Hb, WinT, D, 2048u, 32u, 128u, 2048u}; pg8::Order<pg8::MapG> S; S.init(T / 256, D / 256, G, bx, pg8::MapG{TS2K, TS2K, BIG, 0, BIG});
          pg8::EpiU E{UX, ssqp}; pg8::gemm_phase(lds, g, S, E, wv, RT); }
        { pg8::Gemm g{memn, WkvT, D, 2048u, 32u, 128u, 2048u}; pg8::Order<pg8::MapG> S; S.init(8, 8, G, bx, pg8::MapG{TS2K, TS2K, 4, 8, 4});
          pg8::EpiKV E{Kb}; pg8::gemm_phase(lds, g, S, E, wv); }
        SEAM(1);
    }
    if (IN(2)) {
        { pg8::Gemm g{UX, WSs, KS1, KS3 * 2u, 32u, 128u, KS1 * 2u}; pg8::Order<pg8::MapG> S; S.init(NG * NCH / 256, 1, G, bx, pg8::MapG{256L * KS3 * 2, 256L * KS1 * 2, 4, 1, BIG});
          pg8::EpiF32Plain E{Ssum, 256}; pg8::gemm_phase(lds, g, S, E, wv); }
        struct MapFold { __device__ __forceinline__ void map(int pm, int pn, pg8::Unit& u) const { u.pm = pm; u.pn = pn;
            if (pm < 32) { u.aoff = (long)WS_KB + ((long)(pm >> 2) * 256 * D + (pm & 3) * 256) * 2; u.boff = (long)WS_WQN + ((long)(pm >> 4) * D * D + (long)pn * 256 * D + (pm & 3) * 256) * 2; }
            else { const int pv = pm - 32; u.aoff = (long)WS_WOT + ((long)(pv >> 4) * D * D + (long)(pv & 3) * 256 * D + pn * 256) * 2; u.boff = (long)WS_VB + ((long)(pv >> 2) * 256 * D + pn * 256) * 2; } } };
        { pg8::Gemm g{(const bf16_t*)ws, (const bf16_t*)ws, 256, 2048u, 32u, 128u, 2048u}; pg8::Order<MapFold> S; S.init(64, 4, G, bx, MapFold{});
          pg8::EpiBf16Plain E{WeffT, D}; pg8::gemm_phase(lds, g, S, E, wv); }
        SEAM(2);
    }
    if (IN(3)) {
        PHASE_IDS
        const int g = vcu >> 2, q = vcu & 3, b = vcu & 3;
        ssm_tables_b_load(lds, g, q, Ktab, APW, CCG, tid);
        __syncthreads();
        if (wave < 2) {
            const int r = wave, p = lane; const int gi = (r * 64 + g) * 64 + p;
            const float lr = args.in[8][gi], li = args.in[9][gi], dt = expf(args.in[10][r * 64 + g]);
            const float mag = expf(32.0f * lr * dt), ang = 32.0f * li * dt; const float ax = mag * cosf(ang), ay = mag * sinf(ang);
            float X = 0.f, Y = 0.f;
            const size_t row0 = (size_t)g * NCH + (size_t)b * NCHB;
            for (int c0 = 0; c0 < NCHB; c0 += 8) {
                float sx[8], sy[8];
#pragma unroll
                for (int i = 0; i < 8; ++i) { const int c = r == 0 ? c0 + i : NCHB - 1 - (c0 + i); const float* sp = Ssum + (row0 + c) * 256 + r * 128 + p; sx[i] = sp[0]; sy[i] = sp[64]; }
#pragma unroll
                for (int i = 0; i < 8; ++i) { const int c = r == 0 ? c0 + i : NCHB - 1 - (c0 + i); bf16_t* up = UX + (row0 + c) * KS3 + KS1 + r * 128 + p;
                    const unsigned w = cvt_pk_bf16(X, Y); up[0] = (bf16_t)(w & 0xffffu); up[64] = (bf16_t)(w >> 16);
                    const float nX = ax * X - ay * Y + sx[i], nY = ax * Y + ay * X + sy[i]; X = nX; Y = nY; }
            }
        } else {
            ssm_tables_b_write(lds, g, q, tid - 128, args.in[15], W3);
            LAS float* scr = (LAS float*)(lds + 90112 + (wave - 2) * 8448);
            constexpr int I_DD = 16 * 32, I_BIN = 16 * 96, I_W1 = 16 * 128, I_W2 = 64 * 32;
            for (int it = vcu * 6 + (wave - 2); it < 3 * I_DD + I_BIN + 2 * I_W1 + 2 * I_W2; it += G * 6) {
                int r = it;
                if (transpose_job(r, args.in[16], D, D, nullptr, WgluT, 0, scr, lane)) continue;
                if (transpose_job(r, args.in[17], D, D, nullptr, WoutT, 0, scr, lane)) continue;
                if (transpose_job(r, args.in[24], D, FF, norm_ffn, W1T, 0, scr, lane)) continue;
                if (transpose_job(r, args.in[25], FF, D, nullptr, W2T, 0, scr, lane)) continue;
                if (transpose_job(r, args.in[18], D, 3 * D, norm_mix + D, BinT, 1, scr, lane)) continue;
                if (transpose_job(r, args.in[20], D, D, nullptr, BoutT, 0, scr, lane)) continue;
                if (transpose_job(r, args.in[24] + (size_t)D * FF, D, FF, norm_ffn + D, W1T + (size_t)FF * D, 0, scr, lane)) continue;
                transpose_job(r, args.in[25] + (size_t)FF * D, FF, D, nullptr, W2T + (size_t)D * FF, 0, scr, lane);
            }
        }
        SEAM(3);
    }
    if (IN(4)) {
        pg8::Gemm g{UX, W3, KS3, KS3 * 2u, 32u, 128u, KS3 * 2u}; pg8::Order<pg8::MapG> S; S.init(NG * NCH / 256, 2, G, bx, pg8::MapG{256L * KS3 * 2, 256L * KS3 * 2, 4, 2, BIG});
        pg8::EpiGelu E{Zgm}; pg8::gemm_phase(lds, g, S, E, wv);
        SEAM(4);
    }
    if (IN(5)) {
        pg8::Gemm g{Zgm, WgluT, D, 32u, (unsigned)T * 32u, 4u * (unsigned)T * 32u, 2048u}; pg8::Order<pg8::MapG> S; S.init(T / 256, D / 256, G, bx, pg8::MapG{256L * 32, TS2K, BIG, 0, BIG});
        pg8::EpiGlu E{Zgm, Z2}; pg8::gemm_phase(lds, g, S, E, wv);
        SEAM(5);
    }
    if (IN(6)) {
        pg8::Gemm g{Z2, WoutT, D, 2048u, 32u, 128u, 2048u}; pg8::Order<pg8::MapG> S; S.init(T / 256, D / 256, G, bx, pg8::MapG{TS2K, TS2K, BIG, 0, BIG});
        pg8::EpiRes E{Hb, ssqp}; pg8::gemm_phase(lds, g, S, E, wv);
        SEAM(6);
    }
#pragma unroll
    for (int layer = 0; layer < 2; ++layer) {
        if (layer == 1) {
            if (IN(11)) {
                pg8::Gemm g{Hb, BinT, D, 2048u, 32u, 128u, 2048u}; pg8::Order<pg8::MapG> S; S.init(T / 256, 12, G, bx, pg8::MapG{TS2K, TS2K, BIG, 0, BIG});
                pg8::EpiBCV E{Zbv, Cg, ssqp}; pg8::gemm_phase(lds, g, S, E, wv, RT);
                SEAM(11);
            }
            if (IN(12)) {
                PHASE_IDS
                const float* cw = args.in[19];
                f32x4 w0[4], w1[4], w2[4];
#pragma unroll
                for (int j = 0; j < 4; ++j) { w0[j] = *(const f32x4*)(cw + 16 * lane + 4 * j); w1[j] = *(const f32x4*)(cw + D + 16 * lane + 4 * j); w2[j] = *(const f32x4*)(cw + 2 * D + 16 * lane + 4 * j); }
                for (int blk = gw; blk < T / 16; blk += NGW) {
                    const int t0 = blk * 16; f32x4 pv[4], cv[4], nv[4];
                    if ((t0 & (SEQ - 1)) == 0) {
#pragma unroll
                        for (int j = 0; j < 4; ++j) pv[j] = (f32x4){0.f, 0.f, 0.f, 0.f};
                    } else { const u32x4* zp = (const u32x4*)(Zbv + (size_t)(t0 - 1) * D + 16 * lane); pg8::unpack8(zp[0], pv[0], pv[1]); pg8::unpack8(zp[1], pv[2], pv[3]); }
                    { const u32x4* zp = (const u32x4*)(Zbv + (size_t)t0 * D + 16 * lane); pg8::unpack8(zp[0], cv[0], cv[1]); pg8::unpack8(zp[1], cv[2], cv[3]); }
                    for (int i = 0; i < 16; ++i) { const int t = t0 + i;
                        if ((t & (SEQ - 1)) == SEQ - 1) {
#pragma unroll
                            for (int j = 0; j < 4; ++j) nv[j] = (f32x4){0.f, 0.f, 0.f, 0.f};
                        } else { const u32x4* zp = (const u32x4*)(Zbv + (size_t)(t + 1) * D + 16 * lane); pg8::unpack8(zp[0], nv[0], nv[1]); pg8::unpack8(zp[1], nv[2], nv[3]); }
                        const u32x4* cp = (const u32x4*)(Cg + (size_t)t * D + 16 * lane); f32x4 gc[4]; pg8::unpack8(cp[0], gc[0], gc[1]); pg8::unpack8(cp[1], gc[2], gc[3]);
                        f32x4 o[4];
#pragma unroll
                        for (int j = 0; j < 4; ++j) { o[j] = gc[j] * (w0[j] * pv[j] + w1[j] * cv[j] + w2[j] * nv[j]); pv[j] = cv[j]; cv[j] = nv[j]; }
                        u32x4* op = (u32x4*)(Zc + (size_t)t * D + 16 * lane); op[0] = pg8::pack8(o[0], o[1]); op[1] = pg8::pack8(o[2], o[3]); }
                }
                SEAM(12);
            }
            if (IN(13)) {
                pg8::Gemm g{Zc, BoutT, D, 2048u, 32u, 128u, 2048u}; pg8::Order<pg8::MapG> S; S.init(T / 256, D / 256, G, bx, pg8::MapG{TS2K, TS2K, BIG, 0, BIG});
                pg8::EpiRes E{Hb, ssqp}; pg8::gemm_phase(lds, g, S, E, wv);
                SEAM(13);
            }
        }
        const int pb = layer ? 14 : 7;
        if (IN(pb)) {
            pg8::Gemm g{Hb, WeffT + (size_t)layer * NB * D * D, D, 2048u, 32u, 128u, 2048u}; pg8::Order<pg8::MapG> S; S.init(T / 256, D / 256, G, bx, pg8::MapG{TS2K, TS2K, SEQ / 256, 4, BIG});
            pg8::EpiSoftmax E{Pm, ssqp, (LAS f32x2*)(lds + XCH_OFF)}; pg8::gemm_phase(lds, g, S, E, wv, RT);
            SEAM(pb);
        }
        if (IN(pb + 1)) {
            pg8::Gemm g{Pm, VWT + (size_t)layer * NB * D * D, D, 2048u, 32u, 128u, 2048u}; pg8::Order<pg8::MapG> S; S.init(T / 256, D / 256, G, bx, pg8::MapG{TS2K, TS2K, SEQ / 256, 4, BIG});
            pg8::EpiRes E{Hb, ssqp}; pg8::gemm_phase(lds, g, S, E, wv);
            SEAM(pb + 1);
        }
        if (IN(pb + 2)) {
            pg8::Gemm g{Hb, W1T + (size_t)layer * FF * D, D, 2048u, 32u, 128u, 2048u}; pg8::Order<pg8::MapG> S; S.init(T / 256, FF / 256, G, bx, pg8::MapG{TS2K, TS2K, BIG, 0, BIG});
            pg8::EpiRelu2 E{Aff, ssqp}; pg8::gemm_phase(lds, g, S, E, wv, RT);
            SEAM(pb + 2);
        }
        if (IN(pb + 3)) {
            pg8::Gemm g{Aff, W2T + (size_t)layer * D * FF, FF, 8192u, 32u, 128u, 8192u}; pg8::Order<pg8::MapG> S; S.init(T / 256, D / 256, G, bx, pg8::MapG{256L * 8192, 256L * 8192, BIG, 0, BIG});
            pg8::EpiRes E{Hb, ssqp}; pg8::gemm_phase(lds, g, S, E, wv);
            SEAM(pb + 3);
        }
    }
    if (IN(18)) {
        PHASE_IDS
        f32x4 gn[4];
#pragma unroll
        for (int j = 0; j < 4; ++j) gn[j] = ((const f32x4*)norm_final)[lane + 64 * j];
        for (int t = gw; t < T; t += NGW) { const float ri = pg8::row_rinv(ssqp, t); const u32x2* hp = (const u32x2*)(Hb + (size_t)t * D) + lane; f32x4* op = (f32x4*)(H + (size_t)t * D) + lane;
#pragma unroll
            for (int j = 0; j < 4; ++j) { const u32x2 w = hp[64 * j]; f32x4 v; v[0] = __uint_as_float(w.x << 16); v[1] = __uint_as_float(w.x & 0xffff0000u); v[2] = __uint_as_float(w.y << 16); v[3] = __uint_as_float(w.y & 0xffff0000u);
                op[64 * j] = v * gn[j] * ri; } }
    }
    if (TPROBE >= 0) { if (TPROBE == 18) tp1 = __builtin_amdgcn_s_memrealtime();
        if (wv == 0 && lane_id() == 0) { const unsigned long long target = __builtin_amdgcn_s_memrealtime() + 4ull * (tp1 - tp0); while (__builtin_amdgcn_s_memrealtime() < target) __builtin_amdgcn_s_sleep(20); } }
#undef IN
#undef SEAM
}

extern "C" void kernel_launch(void* const* d_in, const int* in_sizes, int n_in, void* d_out, int out_size, void* d_ws, size_t ws_size, hipStream_t stream) {
    static int grid = 0;
    if (grid == 0) {
        if (n_in != 26 || in_sizes[0] != T * D || out_size != T * D || ws_size < WS_END) {
            fprintf(stderr, "kernel_launch: built for 26 inputs, x/out of %d floats, >= %zu bytes of workspace; got n_in %d, in0 %d, out %d, ws %zu; nothing launched\n", T * D, (size_t)WS_END, n_in, n_in > 0 ? in_sizes[0] : -1, out_size, ws_size);
            grid = -1; return; }
        int dev = 0, cus = 0, per_cu = 0;
        if (hipGetDevice(&dev) != hipSuccess || hipDeviceGetAttribute(&cus, hipDeviceAttributeMultiprocessorCount, dev) != hipSuccess) { fprintf(stderr, "kernel_launch: device query failed\n"); grid = -1; return; }
        if (hipFuncSetAttribute((const void*)trunk_fwd, hipFuncAttributeMaxDynamicSharedMemorySize, LDS_BYTES) != hipSuccess) { fprintf(stderr, "kernel_launch: hipFuncSetAttribute failed\n"); grid = -1; return; }
        if (hipOccupancyMaxActiveBlocksPerMultiprocessor(&per_cu, (const void*)trunk_fwd, NWAVES * 64, LDS_BYTES) != hipSuccess || per_cu < 1)
            fprintf(stderr, "kernel_launch: note: occupancy query reports %d workgroups per CU\n", per_cu);
        (void)hipGetLastError();
        if (cus < 256) { fprintf(stderr, "kernel_launch: built for a 256-CU device (got %d CUs); nothing launched\n", cus); grid = -1; return; }
        grid = 256;
    }
    if (grid < 0) return;
    if (hipMemsetAsync((char*)d_ws + WS_CTL, 0, CTL_ZERO_BYTES, stream) != hipSuccess) { fprintf(stderr, "kernel_launch: hipMemsetAsync failed\n"); return; }
    Args a{};
    for (int i = 0; i < 26; ++i) a.in[i] = (const float*)d_in[i];
    a.out = (float*)d_out; a.ws = (unsigned char*)d_ws;
#if MK_N_LAUNCHES == 1
    a.ph_lo = 0; a.ph_hi = N_PHASES; a.li = 0;
    void* kargs[] = {&a};
    hipError_t e = hipLaunchCooperativeKernel((const void*)trunk_fwd, dim3(grid), dim3(NWAVES * 64), kargs, LDS_BYTES, stream);
    if (e != hipSuccess) { fprintf(stderr, "kernel_launch: cooperative launch failed: %s (grid %d)\n", hipGetErrorString(e), grid); (void)hipGetLastError();
        hipLaunchKernelGGL(trunk_fwd, dim3(grid), dim3(NWAVES * 64), LDS_BYTES, stream, a); }
#else
    for (int ph = 0; ph < N_PHASES; ++ph) { a.ph_lo = ph; a.ph_hi = ph + 1; a.li = ph; hipLaunchKernelGGL(trunk_fwd, dim3(grid), dim3(NWAVES * 64), LDS_BYTES, stream, a); }
#endif
}
```
